# Optimizing an MI355X kernel written in HIP

```python
import jax, jax.numpy as jnp
from jax import lax
import numpy as np

D_MODEL = 1024
BATCH = 8
SEQ = 2048
DEPTH = 1
DEC_BATCH = 128
DEC_SEQ = 8
PAST_LEN = 16384
PAGE_SIZE = 128

N_META = 16
H_A = 4
DV_A = D_MODEL // H_A
DK_A = DV_A // 2
CHUNK_A = 64
N_B = 64
H_B = D_MODEL // N_B
D_B = H_B * N_B
LORA_W = 64
LORA_A = 64
LORA_G = 128
D_FF = 2816
CONV_W = 3
LN_EPS = 1e-5
GN_EPS_B = 64e-5
ALPHA = (2 * DEPTH) ** 0.25
BETA = (8 * DEPTH) ** -0.25
P_A = 2 * H_A * DK_A + 2 * H_A * DV_A + 2 * H_A
P_B = 3 * D_B + LORA_W + LORA_A + LORA_G
OFF_B = 2 * D_MODEL + P_A
P_TOTAL = OFF_B + P_B

kernel_name = "hybrid_mlstm_rwkv7_gated_merge_convffn_step"


def _split(a, sizes):
    return jnp.split(a, np.cumsum(sizes)[:-1].tolist(), axis=-1)


def _layer_norm(x, g, b):
    xf = x.astype(jnp.float32)
    mu = jnp.mean(xf, -1, keepdims=True)
    var = jnp.mean(jnp.square(xf - mu), -1, keepdims=True)
    return ((xf - mu) * lax.rsqrt(var + LN_EPS) * g + b).astype(x.dtype)


def _head_norm(h, eps):
    hf = h.astype(jnp.float32)
    mu = jnp.mean(hf, -1, keepdims=True)
    var = jnp.mean(jnp.square(hf - mu), -1, keepdims=True)
    return (hf - mu) * lax.rsqrt(var + eps)


def _mlstm_chunk(carry, inp):
    C, n, m = carry
    q, k, v, li, lf = inp
    L = q.shape[2]
    b = jnp.cumsum(lf, axis=-1)
    causal = jnp.tril(jnp.ones((L, L), dtype=bool))
    dlog = jnp.where(causal, b[..., :, None] - b[..., None, :] + li[..., None, :], -jnp.inf)
    inter = b + m[..., None]
    m_row = jnp.maximum(inter, jnp.max(dlog, axis=-1))
    s = jnp.einsum('bhtd,bhsd->bhts', q, k) * jnp.exp(dlog - m_row[..., None])
    w_inter = jnp.exp(inter - m_row)
    num = jnp.einsum('bhts,bhsv->bhtv', s, v) + w_inter[..., None] * jnp.einsum('bhtd,bhdv->bhtv', q, C)
    den = jnp.sum(s, -1) + w_inter * jnp.einsum('bhtd,bhd->bht', q, n)
    h = num / jnp.maximum(jnp.abs(den), jnp.exp(-m_row))[..., None]
    b_last = b[..., -1]
    g_log = b_last[..., None] - b + li
    m_new = jnp.maximum(b_last + m, jnp.max(g_log, axis=-1))
    decay = jnp.exp(b_last + m - m_new)
    wk = jnp.exp(g_log - m_new[..., None])
    C_new = decay[..., None, None] * C + jnp.einsum('bhs,bhsd,bhsv->bhdv', wk, k, v)
    n_new = decay[..., None] * n + jnp.einsum('bhs,bhsd->bhd', wk, k)
    return (C_new, n_new, m_new), h


def _mlstm_scan(state, q, k, v, li, lf, L):
    B, H, T = li.shape
    nc = T // L

    def to_chunks(a):
        return jnp.moveaxis(a.reshape(B, H, nc, L, *a.shape[3:]), 2, 0)

    state, h = lax.scan(_mlstm_chunk, state, tuple(to_chunks(a) for a in (q, k, v, li, lf)))
    return state, jnp.moveaxis(h, 0, 2).reshape(B, H, T, DV_A)


def _mlstm_mixer(qA, kA, vA, oA, iA, fA, b_if, norm_g, state, segments):
    B, T, _ = qA.shape
    f32 = jnp.float32

    def heads(a, d):
        return a.reshape(B, T, H_A, d).transpose(0, 2, 1, 3).astype(f32)

    q = heads(qA, DK_A)
    k = heads(kA, DK_A) * (DK_A ** -0.5)
    v = heads(vA, DV_A)
    gates = (jnp.concatenate([iA, fA], -1) + b_if).astype(f32).transpose(0, 2, 1)
    li = gates[:, :H_A]
    lf = jax.nn.log_sigmoid(gates[:, H_A:])
    hs = []
    start = 0
    for length, chunk in segments:
        sl = slice(start, start + length)
        state, h = _mlstm_scan(state, q[:, :, sl], k[:, :, sl], v[:, :, sl], li[:, :, sl], lf[:, :, sl], chunk)
        hs.append(h)
        start += length
    h = jnp.concatenate(hs, axis=2)
    h = _head_norm(h, LN_EPS).transpose(0, 2, 1, 3).reshape(B, T, H_A * DV_A)
    return h * norm_g * jax.nn.sigmoid(oA.astype(f32)), state


def _rwkv7_step(S, inp):
    r, w, k, v, kk, a = inp
    sa = jnp.einsum('bhvk,bhk->bhv', S, -kk)
    S = S * w[:, :, None, :] + sa[..., None] * (kk * a)[:, :, None, :] + v[..., None] * k[:, :, None, :]
    return S, jnp.einsum('bhvk,bhk->bhv', S, r)


def _rwkv7_mixer(x, pB, w_inB, shift0, S0, mu, w0, w2, a0, a2, g2, kk_scale, ka_scale, r_k, lnx_g, lnx_b):
    B, T, _ = pB.shape
    f32 = jnp.float32
    prev = (shift0.astype(x.dtype) @ w_inB)[:, None].astype(pB.dtype)
    pB_prev = jnp.concatenate([prev, pB[:, :-1]], axis=1)
    xs = (pB + (pB_prev - pB) * mu).astype(f32)
    r, k, v, xw, xa, xg = _split(xs, [D_B, D_B, D_B, LORA_W, LORA_A, LORA_G])
    w_log = -jax.nn.softplus(-(w0 + jnp.tanh(xw) @ w2)) - 0.5
    decay = jnp.exp(-jnp.exp(w_log))
    a = jax.nn.sigmoid(a0 + xa @ a2)
    g = jax.nn.sigmoid(xg) @ g2

    def heads(t):
        return t.reshape(B, T, H_B, N_B)

    kk = heads(k * kk_scale)
    kk = kk / jnp.maximum(jnp.sqrt(jnp.sum(jnp.square(kk), -1, keepdims=True)), 1e-12)
    k = k * (1.0 + (a - 1.0) * ka_scale)
    r_h, k_h, v_h, w_h, a_h = heads(r), heads(k), heads(v), heads(decay), heads(a)
    seq = tuple(jnp.moveaxis(t, 1, 0) for t in (r_h, w_h, k_h, v_h, kk, a_h))
    S, y = lax.scan(_rwkv7_step, S0.astype(f32), seq)
    y = jnp.moveaxis(y, 0, 1)
    y = _head_norm(y, GN_EPS_B).reshape(B, T, D_B) * lnx_g + lnx_b
    bonus = jnp.sum(r_h * k_h * r_k.reshape(H_B, N_B), -1, keepdims=True) * v_h
    y = (y + bonus.reshape(B, T, D_B)) * g
    return y, S, x[:, -1]


def _conv_ffn(x1, conv0, w_up, conv_w, conv_b, w_down):
    T = x1.shape[1]
    ag, av = jnp.split(x1 @ w_up, 2, axis=-1)
    a_pad = jnp.concatenate([conv0.astype(ag.dtype), ag], axis=1)
    conv = conv_b + sum(a_pad[:, j:j + T] * conv_w[j] for j in range(CONV_W))
    h = jax.nn.gelu(conv) * av
    return h @ w_down, a_pad[:, T:]


def _layer(x, state, lw, segments):
    C0, n0, m0, S0, shift0, conv0 = state
    f32 = jnp.float32
    proj = x @ lw['w_in']
    gA, gB, qA, kA, vA, oA, iA, fA, pB = _split(
        proj, [D_MODEL, D_MODEL, H_A * DK_A, H_A * DK_A, H_A * DV_A, H_A * DV_A, H_A, H_A, P_B])
    mstate = (C0.astype(f32), n0.astype(f32), m0.astype(f32))
    hA, (C1, n1, m1) = _mlstm_mixer(qA, kA, vA, oA, iA, fA, lw['b_if'], lw['mlstm_norm_g'], mstate, segments)
    hB, S1, shift1 = _rwkv7_mixer(x, pB, lw['w_in'][:, OFF_B:], shift0, S0, lw['rwkv_mu'], lw['rwkv_w0'],
                                  lw['rwkv_w2'], lw['rwkv_a0'], lw['rwkv_a2'], lw['rwkv_g2'], lw['rwkv_kk_scale'],
                                  lw['rwkv_ka_scale'], lw['rwkv_rk'], lw['rwkv_lnx_g'], lw['rwkv_lnx_b'])
    merged = (jax.nn.sigmoid(gA.astype(f32)) * hA + jax.nn.sigmoid(gB.astype(f32)) * hB).astype(x.dtype)
    x1 = _layer_norm(ALPHA * x + merged @ lw['w_out'], lw['ln1_g'], lw['ln1_b'])
    f, conv1 = _conv_ffn(x1, conv0, lw['ffn_w_up'], lw['ffn_conv_w'], lw['ffn_conv_b'], lw['ffn_w_down'])
    x2 = _layer_norm(ALPHA * x1 + f, lw['ln2_g'], lw['ln2_b'])
    return x2, (C1, n1, m1, S1, shift1, conv1)


def setup_inputs(seed: int = 0) -> dict:
    key = jax.random.key(seed)
    ks = jax.random.split(key, 40)
    nrm = jax.random.normal
    f32 = jnp.float32
    L = DEPTH
    b_if = jnp.concatenate([
        -2.0 + 0.5 * nrm(ks[0], (L, H_A), f32),
        jnp.linspace(3.0, 6.0, H_A, dtype=f32) + 0.1 * nrm(ks[1], (L, H_A), f32)], axis=-1)
    return {
        'x_prompt': nrm(ks[2], (BATCH, SEQ, D_MODEL), f32),
        'x_sample': nrm(ks[3], (DEC_BATCH, DEC_SEQ, D_MODEL), f32),
        'state_mlstm_C': 0.1 * nrm(ks[4], (L, DEC_BATCH, H_A, DK_A, DV_A), f32),
        'state_mlstm_n': 0.3 * nrm(ks[5], (L, DEC_BATCH, H_A, DK_A), f32),
        'state_mlstm_m': nrm(ks[6], (L, DEC_BATCH, H_A), f32),
        'state_rwkv_S': 0.1 * nrm(ks[7], (L, DEC_BATCH, H_B, N_B, N_B), f32),
        'state_rwkv_shift': nrm(ks[8], (L, DEC_BATCH, D_MODEL), f32),
        'state_ffn_conv': nrm(ks[9], (L, DEC_BATCH, CONV_W - 1, D_FF), f32),
        'meta_tokens': nrm(ks[10], (N_META, D_MODEL), f32),
        'ln_in_g': 1.0 + 0.05 * nrm(ks[11], (D_MODEL,), f32),
        'ln_in_b': 0.02 * nrm(ks[12], (D_MODEL,), f32),
        'w_in': nrm(ks[13], (L, D_MODEL, P_TOTAL), f32) * D_MODEL ** -0.5,
        'b_if': b_if,
        'mlstm_norm_g': 1.0 + 0.1 * nrm(ks[14], (L, H_A * DV_A), f32),
        'rwkv_mu': jax.random.uniform(ks[15], (L, P_B), f32),
        'rwkv_w0': jax.random.uniform(ks[16], (L, D_B), f32, -6.0, 1.0),
        'rwkv_w2': nrm(ks[17], (L, LORA_W, D_B), f32) * 0.5 * LORA_W ** -0.5,
        'rwkv_a0': 0.1 * nrm(ks[18], (L, D_B), f32),
        'rwkv_a2': nrm(ks[19], (L, LORA_A, D_B), f32) * 0.5 * LORA_A ** -0.5,
        'rwkv_g2': nrm(ks[20], (L, LORA_G, D_B), f32) * LORA_G ** -0.5,
        'rwkv_kk_scale': 0.85 + 0.05 * nrm(ks[21], (L, D_B), f32),
        'rwkv_ka_scale': 1.0 + 0.05 * nrm(ks[22], (L, D_B), f32),
        'rwkv_rk': 0.1 * nrm(ks[23], (L, D_B), f32),
        'rwkv_lnx_g': 1.0 + 0.1 * nrm(ks[24], (L, D_B), f32),
        'rwkv_lnx_b': 0.02 * nrm(ks[25], (L, D_B), f32),
        'w_out': nrm(ks[26], (L, D_MODEL, D_MODEL), f32) * D_MODEL ** -0.5 * BETA,
        'ln1_g': 1.0 + 0.05 * nrm(ks[27], (L, D_MODEL), f32),
        'ln1_b': 0.02 * nrm(ks[28], (L, D_MODEL), f32),
        'ffn_w_up': nrm(ks[29], (L, D_MODEL, 2 * D_FF), f32) * D_MODEL ** -0.5,
        'ffn_conv_w': nrm(ks[30], (L, CONV_W, D_FF), f32) * CONV_W ** -0.5,
        'ffn_conv_b': 0.02 * nrm(ks[31], (L, D_FF), f32),
        'ffn_w_down': nrm(ks[32], (L, D_FF, D_MODEL), f32) * D_FF ** -0.5 * BETA,
        'ln2_g': 1.0 + 0.05 * nrm(ks[33], (L, D_MODEL), f32),
        'ln2_b': 0.02 * nrm(ks[34], (L, D_MODEL), f32),
    }


def reference(x_prompt, x_sample, state_mlstm_C, state_mlstm_n, state_mlstm_m, state_rwkv_S, state_rwkv_shift,
              state_ffn_conv, meta_tokens, ln_in_g, ln_in_b, w_in, b_if, mlstm_norm_g, rwkv_mu, rwkv_w0, rwkv_w2,
              rwkv_a0, rwkv_a2, rwkv_g2, rwkv_kk_scale, rwkv_ka_scale, rwkv_rk, rwkv_lnx_g, rwkv_lnx_b, w_out,
              ln1_g, ln1_b, ffn_w_up, ffn_conv_w, ffn_conv_b, ffn_w_down, ln2_g, ln2_b):
    f32 = jnp.float32
    Bp, Tp, _ = x_prompt.shape
    Bs, Ts, _ = x_sample.shape
    meta = jnp.broadcast_to(meta_tokens.astype(x_prompt.dtype)[None], (Bp, N_META, D_MODEL))
    xp = _layer_norm(jnp.concatenate([meta, x_prompt], axis=1), ln_in_g, ln_in_b)
    xs = _layer_norm(x_sample, ln_in_g, ln_in_b)
    zero_state = (jnp.zeros((Bp, H_A, DK_A, DV_A), f32), jnp.zeros((Bp, H_A, DK_A), f32),
                  jnp.zeros((Bp, H_A), f32), jnp.zeros((Bp, H_B, N_B, N_B), f32),
                  jnp.zeros((Bp, D_MODEL), x_prompt.dtype), jnp.zeros((Bp, CONV_W - 1, D_FF), x_prompt.dtype))
    seg_prompt = [(N_META, N_META), (Tp, CHUNK_A)]
    seg_sample = [(Ts, Ts)]
    p_new, s_new = [], []
    for l in range(DEPTH):
        lw = {'w_in': w_in[l], 'b_if': b_if[l], 'mlstm_norm_g': mlstm_norm_g[l], 'rwkv_mu': rwkv_mu[l],
              'rwkv_w0': rwkv_w0[l], 'rwkv_w2': rwkv_w2[l], 'rwkv_a0': rwkv_a0[l], 'rwkv_a2': rwkv_a2[l],
              'rwkv_g2': rwkv_g2[l], 'rwkv_kk_scale': rwkv_kk_scale[l], 'rwkv_ka_scale': rwkv_ka_scale[l],
              'rwkv_rk': rwkv_rk[l], 'rwkv_lnx_g': rwkv_lnx_g[l], 'rwkv_lnx_b': rwkv_lnx_b[l], 'w_out': w_out[l],
              'ln1_g': ln1_g[l], 'ln1_b': ln1_b[l], 'ffn_w_up': ffn_w_up[l], 'ffn_conv_w': ffn_conv_w[l],
              'ffn_conv_b': ffn_conv_b[l], 'ffn_w_down': ffn_w_down[l], 'ln2_g': ln2_g[l], 'ln2_b': ln2_b[l]}
        xp, st_p = _layer(xp, zero_state, lw, seg_prompt)
        st_in = (state_mlstm_C[l], state_mlstm_n[l], state_mlstm_m[l], state_rwkv_S[l], state_rwkv_shift[l],
                 state_ffn_conv[l])
        xs, st_s = _layer(xs, st_in, lw, seg_sample)
        p_new.append(st_p)
        s_new.append(st_s)

    def stack(lst, i):
        return jnp.stack([st[i] for st in lst], axis=0)

    y_prompt = xp[:, N_META:]
    y_sample = xs
    return (y_prompt, y_sample,
            stack(p_new, 0), stack(p_new, 1), stack(p_new, 2), stack(p_new, 3), stack(p_new, 4), stack(p_new, 5),
            stack(s_new, 0), stack(s_new, 1), stack(s_new, 2), stack(s_new, 3), stack(s_new, 4), stack(s_new, 5))
```

```cpp
#include <hip/hip_runtime.h>
#include <hip/hip_cooperative_groups.h>
#include <cstdio>
#include <cstdint>
namespace cg = cooperative_groups;
namespace pg8 {
#define PG8_LAS __attribute__((address_space(3)))
typedef unsigned short bf16_t;
typedef short bf16x8 __attribute__((ext_vector_type(8)));
typedef float f32x4 __attribute__((ext_vector_type(4)));
typedef unsigned u32x4 __attribute__((ext_vector_type(4)));
constexpr int BM = 256, BK = 64, HALF = 128, HTB = HALF * BK * 2  , STAGE_BYTES = 8 * HTB, NXCD = 8, WGM = 8;

__host__ __device__ __forceinline__ int lds_byte(int r, int c) { const int st = (r >> 4) * 2 + (c >> 5), rr = r & 15, cc = c & 31, ob = rr * 64 + cc * 2; return st * 1024 + (ob ^ (((ob >> 9) & 1) << 5)); }
__host__ __device__ __forceinline__ void stage_rc(int b, int& R, int& C) { const int st = b / 1024, sb = b % 1024, swz = sb ^ (((sb >> 9) & 1) << 5); R = (st >> 1) * 16 + swz / 64; C = (st & 1) * 32 + (swz % 64) / 2; }
__host__ __device__ __forceinline__ int perm32(int rho) { const int n = rho >> 4, i = rho & 15; return 8 * (i >> 2) + 4 * n + (i & 3); }

struct Unit { int pm, pn, nt = 0, kofs = 0, aux = 0; };
struct Gemm { const bf16_t* A; const bf16_t* Bt; int M, N, K, lda, kpA; };

struct StaticOrder {
    int nM, nN, nwg, G, c, off = 0, end = 0;
    __host__ __device__ void init(int M, int N, int G_, int c_) { nM = M / BM; nN = N / BM; nwg = nM * nN; G = G_; c = c_; }
    __host__ __device__ bool next(int i, Unit& u) const {
        const long L = (long)i * G + c + off; if (L >= (end ? end : nwg)) return false;
        int wgid = (int)L; { const int q = nwg / NXCD, r = nwg % NXCD, xcd = wgid % NXCD, off = wgid / NXCD; wgid = (xcd < r ? xcd * (q + 1) : r * (q + 1) + (xcd - r) * q) + off; }
        const int nig = WGM * nN, gid = wgid / nig, fm = gid * WGM, gsz = (nM - fm) < WGM ? (nM - fm) : WGM;
        u.pm = fm + ((wgid % nig) % gsz); u.pn = (wgid % nig) / gsz; return true;
    }
    __device__ __forceinline__ void a_ready(const Unit&) const {}
    __device__ __forceinline__ void done(const Unit&) const {}
};


struct TailSplitOrder {
    StaticOrder base; int ntk;
    __host__ __device__ void init(int M, int N, int K, int G_, int c_) { base.init(M, N, G_, c_); ntk = K / BK; }
    __host__ __device__ bool next(int i, Unit& u) const {
        const int G = base.G, T = base.nwg; StaticOrder b1 = base; b1.G = 1; b1.c = 0;
        if (i == 0) { if (base.c >= T) return false; b1.next(base.c, u); u.nt = 0; u.kofs = 0; return true; }
        if (i == 1) { const int l = base.c; if (l >= 3 * (T - G)) return false; const int tl = l / 3, pc = l - 3 * tl; b1.next(G + tl, u);
            const int n0 = ((ntk / 3 + 2) >> 1) << 1, n1 = (((ntk - n0) / 2 + 1) >> 1) << 1;
            u.nt = pc == 0 ? n0 : (pc == 1 ? n1 : ntk - n0 - n1); u.kofs = pc == 0 ? 0 : (pc == 1 ? n0 : n0 + n1); u.aux = 2 * tl + (pc - 1); return true; }
        return false;
    }
    __device__ __forceinline__ void a_ready(const Unit&) const {}
    __device__ __forceinline__ void done(const Unit&) const {}
};

__device__ __forceinline__ unsigned cvt_pk_bf16(float lo, float hi) { unsigned r; asm volatile("v_cvt_pk_bf16_f32 %0, %1, %2" : "=v"(r) : "v"(lo), "v"(hi)); return r; }
struct EpiProj {
    static constexpr bool PERM = true, AFTER_DRAIN = false;
    bf16_t* O0; int ld0; int nt0; bf16_t* O1; int ld1;
    __device__ __forceinline__ void operator()(const f32x4 (&acc)[2][2][4][2], const Unit& u, int wr, int wc, int fr, int fq) const {
        const bool first = u.pn < nt0; bf16_t* base = first ? O0 : O1; const int ldc = first ? ld0 : ld1; const int colt = (first ? u.pn : u.pn - nt0) * BM;
        const int row0 = u.pm * BM + wr * 64 + fr, col0 = colt + wc * 32 + 8 * fq;
#pragma unroll
        for (int ai = 0; ai < 2; ++ai)
#pragma unroll
            for (int m = 0; m < 4; ++m) { bf16_t* rowp = base + (size_t)(row0 + ai * HALF + m * 16) * ldc + col0;
#pragma unroll
                for (int bj = 0; bj < 2; ++bj) { const f32x4 v0 = acc[ai][bj][m][0], v1 = acc[ai][bj][m][1];
                    u32x4 w; w.x = cvt_pk_bf16(v0[0], v0[1]); w.y = cvt_pk_bf16(v0[2], v0[3]); w.z = cvt_pk_bf16(v1[0], v1[1]); w.w = cvt_pk_bf16(v1[2], v1[3]);
                    *(u32x4*)(rowp + bj * HALF) = w; } }
    }
};

struct EpiSigU8 {
    static constexpr bool PERM = true, AFTER_DRAIN = false;
    unsigned char* O; int ldc;
    __device__ __forceinline__ unsigned q8(float x) const { return (unsigned)(__builtin_amdgcn_rcpf(1.f + __expf(-x)) * 255.f + 0.5f); }
    __device__ __forceinline__ void operator()(const f32x4 (&acc)[2][2][4][2], const Unit& u, int wr, int wc, int fr, int fq) const {
        const int row0 = u.pm * BM + wr * 64 + fr, col0 = u.pn * BM + wc * 32 + 8 * fq;
#pragma unroll
        for (int ai = 0; ai < 2; ++ai)
#pragma unroll
            for (int m = 0; m < 4; ++m) { unsigned char* rowp = O + (size_t)(row0 + ai * HALF + m * 16) * ldc + col0;
#pragma unroll
                for (int bj = 0; bj < 2; ++bj) { const f32x4 v0 = acc[ai][bj][m][0], v1 = acc[ai][bj][m][1];
                    unsigned long long w = (unsigned long long)(q8(v0[0]) | (q8(v0[1]) << 8) | (q8(v0[2]) << 16) | (q8(v0[3]) << 24)) |
                                           ((unsigned long long)(q8(v1[0]) | (q8(v1[1]) << 8) | (q8(v1[2]) << 16) | (q8(v1[3]) << 24)) << 32);
                    *(unsigned long long*)(rowp + bj * HALF) = w; } }
    }
};
__device__ __forceinline__ float bf_lo(unsigned x) { return __builtin_bit_cast(float, x << 16); }
__device__ __forceinline__ float bf_hi(unsigned x) { return __builtin_bit_cast(float, x & 0xffff0000u); }
template <bool YMAP> struct EpiRes {
    static constexpr bool PERM = true, AFTER_DRAIN = false;
    const bf16_t* X; float* O; float alpha_; float* part;
    __device__ __forceinline__ void operator()(const f32x4 (&acc)[2][2][4][2], const Unit& u, int wr, int wc, int fr, int fq) const {
        const int row0 = u.pm * BM + wr * 64 + fr, col0 = u.pn * BM + wc * 32 + 8 * fq;
        if (YMAP && u.nt != 0 && u.kofs != 0) {
            float* pb = part + (size_t)u.aux * 65536 + (size_t)(wr * 64 + fr) * 256 + wc * 32 + 8 * fq;
#pragma unroll
            for (int ai = 0; ai < 2; ++ai)
#pragma unroll
                for (int m = 0; m < 4; ++m)
#pragma unroll
                    for (int bj = 0; bj < 2; ++bj) { float* op = pb + (size_t)(ai * HALF + m * 16) * 256 + bj * HALF; *(f32x4*)op = acc[ai][bj][m][0]; *(f32x4*)(op + 4) = acc[ai][bj][m][1]; }
            return;
        }
#pragma unroll
        for (int ai = 0; ai < 2; ++ai)
#pragma unroll
            for (int m = 0; m < 4; ++m) { const int row = row0 + ai * HALF + m * 16; int orow = row;
                if (YMAP) { if (row < 16512) { const int b = row / 2064, t = row - b * 2064; orow = t < 16 ? -1 : b * 2048 + t - 16; } else if (row < 17536) orow = row - 128; else orow = -1; }
                if (orow >= 0) {
#pragma unroll
                for (int bj = 0; bj < 2; ++bj) { const u32x4 x = *(const u32x4*)(X + (size_t)row * 1024 + col0 + bj * HALF);
                    f32x4 o0 = acc[ai][bj][m][0], o1 = acc[ai][bj][m][1]; const float alpha = alpha_;
                    o0[0] += alpha * bf_lo(x.x); o0[1] += alpha * bf_hi(x.x); o0[2] += alpha * bf_lo(x.y); o0[3] += alpha * bf_hi(x.y);
                    o1[0] += alpha * bf_lo(x.z); o1[1] += alpha * bf_hi(x.z); o1[2] += alpha * bf_lo(x.w); o1[3] += alpha * bf_hi(x.w);
                    float* op = O + (size_t)orow * 1024 + col0 + bj * HALF;
                    *(f32x4*)op = o0; *(f32x4*)(op + 4) = o1; } } }
    }
};
template <class Epi, class Sched, bool ALIGN_EPI = false, bool SP2 = false>
__device__ __forceinline__ void gemm_phase(PG8_LAS unsigned char* lds, const Gemm g, const Sched& S, const Epi& E) {
    int tid_ = threadIdx.x; asm volatile("" : "+v"(tid_));
    const int tid = tid_, wid = __builtin_amdgcn_readfirstlane(tid >> 6), lane = tid & 63, wr = wid >> 2, wc = wid & 3, fr = lane & 15, fq = lane >> 4;
    const int K = g.K, nt_all = K / BK;
    unsigned voffA[2], voffB[2];
#pragma unroll
    for (int i = 0; i < 2; ++i) { int R, C; stage_rc(tid * 16 + i * 8192, R, C); const int Rb = Epi::PERM ? ((R & ~31) + perm32(R & 31)) : R;
        voffA[i] = (unsigned)(R * g.lda + C) * 2u; voffB[i] = (unsigned)(Rb * K + C) * 2u; }
    const size_t kstep = (size_t)(BK * 2);
    const size_t hstepA = (size_t)HALF * g.lda * 2, hstepB = (size_t)HALF * K * 2, kpA = (size_t)g.kpA;
    const size_t tstepA = 2 * hstepA, tstepB = 2 * hstepB;
    const unsigned ldsw = (unsigned)wid * 1024u;
    const int aoff = lds_byte(wr * 64 + fr, fq * 8), boff = lds_byte(wc * 32 + fr, fq * 8);
#define PG8_SA(b, h) (((b) * 2 + (h)) * HTB)
#define PG8_SB(b, h) ((4 + (b) * 2 + (h)) * HTB)
#define PG8_STAGE(bufoff, gbase, voff) do { _Pragma("unroll") for (int _i = 0; _i < 2; ++_i) \
        __builtin_amdgcn_global_load_lds((const unsigned*)((const char*)(gbase) + (voff)[_i]), (PG8_LAS unsigned*)(lds + (bufoff) + ldsw + _i * 8192), 16, 0, 0); } while (0)
#define PG8_LDA(dst, b, h) do { _Pragma("unroll") for (int m = 0; m < 4; ++m) _Pragma("unroll") for (int k = 0; k < 2; ++k) dst[m][k] = *(const PG8_LAS bf16x8*)(lds + PG8_SA(b, h) + aoff + m * 2048 + k * 1024); } while (0)
#define PG8_LDB(dst, b, h) do { _Pragma("unroll") for (int n = 0; n < 2; ++n) _Pragma("unroll") for (int k = 0; k < 2; ++k) dst[n][k] = *(const PG8_LAS bf16x8*)(lds + PG8_SB(b, h) + boff + n * 2048 + k * 1024); } while (0)
#define PG8_MMA(ai, bj, At, Bt) do { __builtin_amdgcn_s_setprio(1); _Pragma("unroll") for (int m = 0; m < 4; ++m) _Pragma("unroll") for (int n = 0; n < 2; ++n) _Pragma("unroll") for (int k = 0; k < 2; ++k) \
        acc[ai][bj][m][n] = __builtin_amdgcn_mfma_f32_16x16x32_bf16(Bt[n][k], At[m][k], acc[ai][bj][m][n], 0, 0, 0); __builtin_amdgcn_s_setprio(0); } while (0)
#define PG8_WAIT_V(n) asm volatile("s_waitcnt vmcnt(" #n ")" ::: "memory")
#define PG8_WAIT_L(n) asm volatile("s_waitcnt lgkmcnt(" #n ")" ::: "memory")
#define PG8_BAR __builtin_amdgcn_s_barrier()
#define PG8_SCHED __builtin_amdgcn_sched_barrier(0)
    Unit cur, nxt; int ui = 0;
    if (!S.next(0, cur)) return;
    f32x4 acc[2][2][4][2];
#pragma unroll
    for (int a = 0; a < 2; ++a)
#pragma unroll
        for (int b = 0; b < 2; ++b)
#pragma unroll
            for (int m = 0; m < 4; ++m)
#pragma unroll
                for (int n = 0; n < 2; ++n) acc[a][b][m][n] = (f32x4){0.f, 0.f, 0.f, 0.f};
    bf16x8 At[4][2], B0[2][2], B1[2][2];
    const char* cA = (const char*)g.A + (size_t)cur.pm * tstepA + (size_t)(cur.kofs >> 1) * kpA; const char* cB = (const char*)g.Bt + (size_t)cur.pn * tstepB + (size_t)cur.kofs * kstep;
    S.a_ready(cur);
    if constexpr (SP2) {
        PG8_STAGE(PG8_SB(0, 0), cB, voffB); PG8_STAGE(PG8_SB(0, 1), cB + hstepB, voffB); PG8_STAGE(PG8_SA(0, 0), cA, voffA); PG8_STAGE(PG8_SA(0, 1), cA + hstepA, voffA);
        if (wr == 1) PG8_BAR;
        PG8_WAIT_V(2); PG8_BAR;
        PG8_STAGE(PG8_SB(1, 0), cB + kstep, voffB); PG8_STAGE(PG8_SA(1, 0), cA + kstep, voffA); PG8_STAGE(PG8_SB(1, 1), cB + hstepB + kstep, voffB);
        PG8_WAIT_V(6); PG8_BAR;
    } else {
        PG8_STAGE(PG8_SB(0, 0), cB, voffB); PG8_STAGE(PG8_SA(0, 0), cA, voffA); PG8_STAGE(PG8_SB(0, 1), cB + hstepB, voffB); PG8_STAGE(PG8_SA(0, 1), cA + hstepA, voffA);
        if (wr == 1) PG8_BAR;
        PG8_WAIT_V(4); PG8_BAR;
        PG8_STAGE(PG8_SB(1, 0), cB + kstep, voffB); PG8_STAGE(PG8_SA(1, 0), cA + kstep, voffA); PG8_STAGE(PG8_SB(1, 1), cB + hstepB + kstep, voffB);
        PG8_WAIT_V(6); PG8_BAR;
    }
    for (;;) {
        const bool has_next = S.next(ui + 1, nxt);
        const char* nA = has_next ? (const char*)g.A + (size_t)nxt.pm * tstepA + (size_t)(nxt.kofs >> 1) * kpA : cA; const char* nB = has_next ? (const char*)g.Bt + (size_t)nxt.pn * tstepB + (size_t)nxt.kofs * kstep : cB;
        const int nt = cur.nt ? cur.nt : nt_all;
        for (int t = 0; t < nt; t += 2) {
            const bool last = (t == nt - 2);
            const char* a1 = cA + (size_t)(t >> 1) * kpA + kstep;
            const char* a2 = last ? nA : cA + (size_t)((t >> 1) + 1) * kpA; const char* b2 = last ? nB : cB + (size_t)(t + 2) * kstep;
            const char* a3 = a2 + kstep; const char* b3 = b2 + kstep;
            if (last && has_next) S.a_ready(nxt);
            if constexpr (SP2) {
            PG8_LDB(B0, 0, 0); PG8_LDB(B1, 0, 1); PG8_SCHED; PG8_LDA(At, 0, 0); PG8_STAGE(PG8_SA(1, 1), a1 + hstepA, voffA);
            PG8_WAIT_V(8); PG8_WAIT_L(0); PG8_BAR; PG8_MMA(0, 0, At, B0); PG8_MMA(0, 1, At, B1); PG8_BAR; PG8_SCHED;
            PG8_LDA(At, 0, 1); PG8_STAGE(PG8_SB(0, 0), b2, voffB); PG8_STAGE(PG8_SB(0, 1), b2 + hstepB, voffB); PG8_STAGE(PG8_SA(0, 0), a2, voffA);
            PG8_WAIT_V(8); PG8_WAIT_L(0); PG8_BAR; PG8_MMA(1, 0, At, B0); PG8_MMA(1, 1, At, B1); PG8_BAR; PG8_SCHED;
            PG8_LDB(B0, 1, 0); PG8_LDB(B1, 1, 1); PG8_SCHED; PG8_LDA(At, 1, 0); PG8_STAGE(PG8_SA(0, 1), a2 + hstepA, voffA);
            PG8_WAIT_V(8); PG8_WAIT_L(0); PG8_BAR; PG8_MMA(0, 0, At, B0); PG8_MMA(0, 1, At, B1); PG8_BAR; PG8_SCHED;
            PG8_LDA(At, 1, 1); PG8_STAGE(PG8_SB(1, 0), b3, voffB); PG8_STAGE(PG8_SB(1, 1), b3 + hstepB, voffB); PG8_STAGE(PG8_SA(1, 0), a3, voffA);
            PG8_WAIT_V(8); PG8_WAIT_L(0); PG8_BAR; PG8_MMA(1, 0, At, B0); PG8_MMA(1, 1, At, B1); PG8_BAR; PG8_SCHED;
            } else {
            PG8_LDB(B0, 0, 0); PG8_SCHED; PG8_LDA(At, 0, 0); PG8_STAGE(PG8_SA(1, 1), a1 + hstepA, voffA);
            PG8_WAIT_L(8); PG8_BAR; PG8_WAIT_L(0); PG8_MMA(0, 0, At, B0); PG8_BAR; PG8_SCHED;
            PG8_LDB(B1, 0, 1); PG8_STAGE(PG8_SB(0, 0), b2, voffB);
            PG8_BAR; PG8_WAIT_L(0); PG8_MMA(0, 1, At, B1); PG8_BAR;
            PG8_LDA(At, 0, 1); PG8_STAGE(PG8_SA(0, 0), a2, voffA);
            PG8_BAR; PG8_WAIT_L(0); PG8_MMA(1, 0, At, B0); PG8_BAR; PG8_SCHED;
            PG8_STAGE(PG8_SB(0, 1), b2 + hstepB, voffB);
            PG8_WAIT_V(6); PG8_BAR; PG8_MMA(1, 1, At, B1); PG8_BAR;
            PG8_LDB(B0, 1, 0); PG8_SCHED; PG8_LDA(At, 1, 0); PG8_STAGE(PG8_SA(0, 1), a2 + hstepA, voffA);
            PG8_WAIT_L(8); PG8_BAR; PG8_WAIT_L(0); PG8_MMA(0, 0, At, B0); PG8_BAR; PG8_SCHED;
            PG8_LDB(B1, 1, 1); PG8_STAGE(PG8_SB(1, 0), b3, voffB);
            PG8_BAR; PG8_WAIT_L(0); PG8_MMA(0, 1, At, B1); PG8_BAR;
            PG8_LDA(At, 1, 1); PG8_STAGE(PG8_SA(1, 0), a3, voffA);
            PG8_BAR; PG8_WAIT_L(0); PG8_MMA(1, 0, At, B0); PG8_BAR; PG8_SCHED;
            PG8_STAGE(PG8_SB(1, 1), b3 + hstepB, voffB);
            PG8_WAIT_V(6); PG8_BAR; PG8_MMA(1, 1, At, B1); PG8_BAR;
            }
        }
        if constexpr (ALIGN_EPI) { if (wr == 0) PG8_BAR; }
        if constexpr (!Epi::AFTER_DRAIN) { E(acc, cur, wr, wc, fr, fq); S.done(cur); }
        if (!has_next) break;
#pragma unroll
        for (int a = 0; a < 2; ++a)
#pragma unroll
            for (int b = 0; b < 2; ++b)
#pragma unroll
                for (int m = 0; m < 4; ++m)
#pragma unroll
                    for (int n = 0; n < 2; ++n) acc[a][b][m][n] = (f32x4){0.f, 0.f, 0.f, 0.f};
        cur = nxt; cA = nA; cB = nB; ++ui;
        if constexpr (ALIGN_EPI) { if (wr == 1) PG8_BAR; }
    }
    PG8_WAIT_V(0);
    if constexpr (!ALIGN_EPI) { if (wr == 0) PG8_BAR; }
    PG8_BAR;
    if constexpr (Epi::AFTER_DRAIN) { E.fused(acc, cur, wr, wc, fr, fq, lds, wid, lane); S.done(cur); }
#undef PG8_SA
#undef PG8_SB
#undef PG8_STAGE
#undef PG8_LDA
#undef PG8_LDB
#undef PG8_MMA
#undef PG8_WAIT_V
#undef PG8_WAIT_L
#undef PG8_BAR
#undef PG8_SCHED
}
}


constexpr int DM = 1024, BP = 8, TP = 2064, NMETA = 16, BS = 128, TS = 8;
constexpr int NP = BP * TP;
constexpr int NS = BS * TS;
constexpr int NTOK = NP + NS;
constexpr int MROWS = NTOK + BS;
constexpr int PTOT = 8456, OFFB = 5128, PBW = 3328, DFF = 2816;
constexpr float ALPHA = 1.189207115002721f;
constexpr float LN_EPS = 1e-5f, GN_EPS_B = 64e-5f;
constexpr size_t O_YP = 0, O_YS = O_YP + (size_t)8 * 2048 * 1024, O_PC = O_YS + (size_t)128 * 8 * 1024, O_PN = O_PC + (size_t)8 * 4 * 128 * 256,
    O_PM = O_PN + 8 * 4 * 128, O_PS = O_PM + 32, O_PSH = O_PS + (size_t)8 * 16 * 4096, O_PCV = O_PSH + 8 * 1024, O_SC = O_PCV + 8 * 2 * 2816,
    O_SN = O_SC + (size_t)128 * 4 * 128 * 256, O_SM = O_SN + 128 * 4 * 128, O_SS = O_SM + 512, O_SSH = O_SS + (size_t)128 * 16 * 4096, O_SCV = O_SSH + 128 * 1024,
    O_END = O_SCV + (size_t)128 * 2 * 2816;
constexpr size_t MiB = 1u << 20;
constexpr size_t WS_CTL = 0, WS_IFG = 1 * MiB, WS_WUP = 2 * MiB, WS_WD = 13 * MiB, WS_XN = 18 * MiB + MiB / 2, WS_WO = 53 * MiB, WS_WIN = 55 * MiB,
    WS_PB = 71 * MiB + MiB / 2, WS_QKV = 183 * MiB + 5 * MiB / 8, WS_G1 = WS_PB, WS_PRE1 = WS_QKV, WS_UP = 66 * MiB + MiB / 4, WS_END = 256 * MiB;
static_assert(WS_WUP + (size_t)5632 * 1024 * 2 <= WS_WD && WS_WD + (size_t)1024 * 2816 * 2 <= WS_XN && WS_XN + (size_t)MROWS * 1024 * 2 <= WS_WO && WS_WO + (size_t)1024 * 1024 * 2 <= WS_WIN &&
              WS_WIN + (size_t)8448 * 1024 * 2 <= WS_PB && WS_PB + (size_t)MROWS * PBW * 2 <= WS_QKV && WS_QKV + (size_t)MROWS * 2048 * 2 <= WS_END && WS_G1 + (size_t)MROWS * 3072 * 2 <= WS_QKV &&
              WS_PRE1 + (size_t)MROWS * 1024 * 4 <= WS_END && WS_UP + (size_t)MROWS * 5632 * 2 <= WS_END && WS_UP >= WS_WO + (size_t)1024 * 1024 * 2, "d_ws map");
constexpr size_t OUT_ALG = 52 * MiB;
static_assert(OUT_ALG >= (size_t)MROWS * 3072 && OUT_ALG + (size_t)NTOK * 256 * 2 <= (size_t)O_PC * 4, "y-region staging");
constexpr int G1_SPLIT = 512;
constexpr size_t WS_PART = 56 * MiB;
constexpr int LDS_BYTES = 157696, LDS_CTL = LDS_BYTES - 256;

#define LAS __attribute__((address_space(3)))
typedef unsigned short bf16;
typedef unsigned v4u __attribute__((ext_vector_type(4)));
typedef unsigned v2u __attribute__((ext_vector_type(2)));
typedef float f32x4 __attribute__((ext_vector_type(4)));
typedef float f32x2 __attribute__((ext_vector_type(2)));
typedef short bf16x8 __attribute__((ext_vector_type(8)));
#define LDS_WAIT() asm volatile("s_waitcnt lgkmcnt(0)" ::: "memory")

__device__ __forceinline__ unsigned f2bf(float f) { unsigned u = __builtin_bit_cast(unsigned, f); return (u + 0x7fffu + ((u >> 16) & 1u)) >> 16; }
typedef __bf16 bf16x2_t __attribute__((ext_vector_type(2)));
__device__ __forceinline__ unsigned pk2(float lo, float hi) { f32x2 v = {lo, hi}; return __builtin_bit_cast(unsigned, __builtin_convertvector(v, bf16x2_t)); }
__device__ __forceinline__ float bflo(unsigned x) { return __builtin_bit_cast(float, x << 16); }
__device__ __forceinline__ float bfhi(unsigned x) { return __builtin_bit_cast(float, x & 0xffff0000u); }
__device__ __forceinline__ float bf2f(bf16 x) { return __builtin_bit_cast(float, (unsigned)x << 16); }
template <int CTRL> __device__ __forceinline__ float dppf(float x) { return __builtin_bit_cast(float, __builtin_amdgcn_update_dpp(0, __builtin_bit_cast(int, x), CTRL, 0xf, 0xf, false)); }
__device__ __forceinline__ float red8(float x) { x += dppf<0xB1>(x); x += dppf<0x4E>(x); x += dppf<0x141>(x); return x; }
__device__ __forceinline__ float red16(float x) { x += dppf<0xB1>(x); x += dppf<0x4E>(x); x += dppf<0x141>(x); x += dppf<0x140>(x); return x; }
__device__ __forceinline__ float wave_sum(float v) { v = red16(v); v += __shfl_xor(v, 16); v += __shfl_xor(v, 32); return v; }
template <int CTRL, int RMASK> __device__ __forceinline__ float dpp_id(float x, float ident) { return __builtin_bit_cast(float, __builtin_amdgcn_update_dpp(__builtin_bit_cast(int, ident), __builtin_bit_cast(int, x), CTRL, RMASK, 0xf, false)); }
__device__ __forceinline__ float wave_scan_sum(float x) {
    x += dpp_id<0x111, 0xf>(x, 0.f); x += dpp_id<0x112, 0xf>(x, 0.f); x += dpp_id<0x114, 0xf>(x, 0.f); x += dpp_id<0x118, 0xf>(x, 0.f);
    x += dpp_id<0x142, 0xa>(x, 0.f); x += dpp_id<0x143, 0xc>(x, 0.f); return x; }
__device__ __forceinline__ float wave_scan_max(float x) {
    const float ni = -__builtin_inff();
    x = fmaxf(x, dpp_id<0x111, 0xf>(x, ni)); x = fmaxf(x, dpp_id<0x112, 0xf>(x, ni)); x = fmaxf(x, dpp_id<0x114, 0xf>(x, ni)); x = fmaxf(x, dpp_id<0x118, 0xf>(x, ni));
    x = fmaxf(x, dpp_id<0x142, 0xa>(x, ni)); x = fmaxf(x, dpp_id<0x143, 0xc>(x, ni)); return x; }
__device__ __forceinline__ bf16 bf1(float x) { return (bf16)(pk2(x, x) & 0xffffu); }
__device__ __forceinline__ float sigmoidf_(float x) { return __builtin_amdgcn_rcpf(1.f + __expf(-x)); }
__device__ __forceinline__ float tanhf_(float x) { return 1.f - 2.f * __builtin_amdgcn_rcpf(__expf(2.f * x) + 1.f); }
__device__ __forceinline__ float softplusf_(float z) { return fmaxf(z, 0.f) + __logf(1.f + __expf(-fabsf(z))); }

struct Args { const float* in[34]; float* out; unsigned char* ws; };
enum { I_XP = 0, I_XS, I_MC, I_MN, I_MM, I_RS, I_RSH, I_FCV, I_META, I_LNG, I_LNB, I_WIN, I_BIF, I_MNG, I_MU, I_W0, I_W2, I_A0, I_A2, I_G2, I_KKS, I_KAS, I_RK, I_LXG, I_LXB,
       I_WOUT, I_L1G, I_L1B, I_WUP, I_CW, I_CB, I_WDN, I_L2G, I_L2B };

__device__ __forceinline__ void transpose_item(const float* W, int ldw, bf16* WT, int ldt, int k0, int src_n0, int dst_n0, LAS float* scr, int lane) {
    float tv[32];
#pragma unroll
    for (int i = 0; i < 32; ++i) tv[i] = W[(size_t)(k0 + 2 * i + (lane >> 5)) * ldw + src_n0 + (lane & 31)];
#pragma unroll
    for (int i = 0; i < 32; ++i) scr[(2 * i + (lane >> 5)) * 33 + (lane & 31)] = tv[i];
    LDS_WAIT(); asm volatile("" ::: "memory");
    const int c = lane & 7;
#pragma unroll
    for (int j = 0; j < 4; ++j) { const int n = (lane >> 3) + 8 * j; const LAS float* s = scr + (8 * c) * 33 + n;
        v4u o; o.x = pk2(s[0 * 33], s[1 * 33]); o.y = pk2(s[2 * 33], s[3 * 33]); o.z = pk2(s[4 * 33], s[5 * 33]); o.w = pk2(s[6 * 33], s[7 * 33]);
        *(v4u*)(WT + (size_t)(dst_n0 + n) * ldt + k0 + 8 * c) = o; }
    LDS_WAIT(); asm volatile("" ::: "memory");
}
__device__ __forceinline__ void weight_items(const Args& A, LAS unsigned char* lds, int part, int gw, int NGW, int wave, int lane) {
    unsigned char* ws = A.ws;
    bf16* WinT = (bf16*)(ws + WS_WIN); bf16* WoT = (bf16*)(ws + WS_WO); bf16* WupT = (bf16*)(ws + WS_WUP); bf16* WdT = (bf16*)(ws + WS_WD);
    LAS float* scr = (LAS float*)(lds + wave * 16384);
    constexpr int IA = 16 * 104, IB = 16 * 64, IC = 16 * 64, ID = 16 * 32, IE = 16 * 32, IF_ = 16 * 176, IG = 44 * 32;
    constexpr int N0 = IA + IB + IC + ID, N1 = IE + IF_ + IG;
    const float* w_in = A.in[I_WIN];
    for (int it = gw; it < (part ? N1 : N0); it += NGW) {
        int r = it + (part ? N0 : 0);
        if (r < IA) { const int kb = r / 104, nb = r % 104; transpose_item(w_in, PTOT, WinT, 1024, 64 * kb, OFFB + 32 * nb, 32 * nb, scr, lane); continue; } r -= IA;
        if (r < IB) { const int kb = r / 64, nb = r % 64; transpose_item(w_in, PTOT, WinT, 1024, 64 * kb, 2048 + 32 * nb, 3328 + 32 * nb, scr, lane); continue; } r -= IB;
        if (r < IC) { const int kb = r / 64, nb = r % 64; transpose_item(w_in, PTOT, WinT, 1024, 64 * kb, 32 * nb, 5376 + 32 * nb, scr, lane); continue; } r -= IC;
        if (r < ID) { const int kb = r / 32, nb = r % 32; transpose_item(w_in, PTOT, WinT, 1024, 64 * kb, 4096 + 32 * nb, 7424 + 32 * nb, scr, lane); continue; } r -= ID;
        if (r < IE) { const int kb = r / 32, nb = r % 32; transpose_item(A.in[I_WOUT], 1024, WoT, 1024, 64 * kb, 32 * nb, 32 * nb, scr, lane); continue; } r -= IE;
        if (r < IF_) { const int kb = r / 176, nb = r % 176; const int n0 = 32 * nb, j = n0 >> 8, c = n0 & 255; const int src = c < 128 ? 128 * j + c : DFF + 128 * j + (c - 128);
                       transpose_item(A.in[I_WUP], 2 * DFF, WupT, 1024, 64 * kb, src, n0, scr, lane); continue; } r -= IF_;
        { const int kb = r / 32, nb = r % 32; transpose_item(A.in[I_WDN], 1024, WdT, DFF, 64 * kb, 32 * nb, 32 * nb, scr, lane); }
    }
}
__device__ __forceinline__ void p0_prologue(const Args& A, LAS unsigned char* lds, int gw, int NGW, int wave, int lane, int tid, bool defer) {
    unsigned char* ws = A.ws;
    bf16* WinT = (bf16*)(ws + WS_WIN); bf16* WoT = (bf16*)(ws + WS_WO); bf16* WupT = (bf16*)(ws + WS_WUP); bf16* WdT = (bf16*)(ws + WS_WD); bf16* XN = (bf16*)(ws + WS_XN);
    float* IFG = (float*)(ws + WS_IFG);
    LAS float* scr = (LAS float*)(lds + wave * 16384);
    weight_items(A, lds, 0, gw, NGW, wave, lane);
    if (!defer) weight_items(A, lds, 1, gw, NGW, wave, lane);
    const float* w_in = A.in[I_WIN];
    __syncthreads();
    LAS float* wif = (LAS float*)lds;
    for (int i = tid; i < 8192; i += 512) { const int k = i >> 3, g = i & 7; wif[g * 1024 + k] = w_in[(size_t)k * PTOT + 5120 + g]; }
    __syncthreads();
    const float* lng = A.in[I_LNG]; const float* lnb = A.in[I_LNB]; const float* bif = A.in[I_BIF];
    f32x4 nx[4];
#define P0_LD(mm) do { const int m_ = (mm); const float* src_; \
        if (m_ < NP) { const int b_ = m_ / TP, t_ = m_ - b_ * TP; src_ = t_ < NMETA ? A.in[I_META] + (size_t)t_ * DM : A.in[I_XP] + ((size_t)b_ * 2048 + (t_ - NMETA)) * DM; } \
        else if (m_ < NTOK) src_ = A.in[I_XS] + (size_t)(m_ - NP) * DM; else src_ = A.in[I_RSH] + (size_t)(m_ - NTOK) * DM; \
        const f32x4* xr_ = (const f32x4*)src_ + lane; _Pragma("unroll") for (int j = 0; j < 4; ++j) nx[j] = xr_[64 * j]; } while (0)
    if (gw < MROWS) P0_LD(gw);
    for (int m = gw; m < MROWS; m += NGW) {
        float* shout = nullptr;
        if (m < NP) { const int b = m / TP, t = m - b * TP; if (t == TP - 1) shout = A.out + O_PSH + (size_t)b * DM; }
        else if (m < NTOK) { const int i = m - NP; if ((i & 7) == 7) shout = A.out + O_SSH + (size_t)(i >> 3) * DM; }
        f32x4 v[4];
#pragma unroll
        for (int j = 0; j < 4; ++j) v[j] = nx[j];
        if (m + NGW < MROWS) P0_LD(m + NGW);
        unsigned long long* o8 = (unsigned long long*)(XN + (size_t)m * DM) + lane;
        if (m < NTOK) {
            float s = 0.f;
#pragma unroll
            for (int j = 0; j < 4; ++j) s += (v[j].x + v[j].y) + (v[j].z + v[j].w);
            const float mean = wave_sum(s) * (1.f / DM); float s2 = 0.f;
#pragma unroll
            for (int j = 0; j < 4; ++j) { v[j] = v[j] - mean; s2 += (v[j].x * v[j].x + v[j].y * v[j].y) + (v[j].z * v[j].z + v[j].w * v[j].w); }
            const float rstd = __builtin_amdgcn_rsqf(wave_sum(s2) * (1.f / DM) + LN_EPS);
            float ga[8];
#pragma unroll
            for (int g = 0; g < 8; ++g) ga[g] = 0.f;
#pragma unroll
            for (int j = 0; j < 4; ++j) { const f32x4 gg = ((const f32x4*)lng)[lane + 64 * j], bb = ((const f32x4*)lnb)[lane + 64 * j]; v[j] = v[j] * rstd * gg + bb;
#pragma unroll
                for (int g = 0; g < 8; ++g) { const f32x4 w = *(const LAS f32x4*)(wif + g * 1024 + 256 * j + 4 * lane); ga[g] += (v[j].x * w.x + v[j].y * w.y) + (v[j].z * w.z + v[j].w * w.w); } }
#pragma unroll
            for (int g = 0; g < 8; ++g) ga[g] = wave_sum(ga[g]);
            if (lane < 8) { float val = ga[0];
#pragma unroll
                for (int g = 1; g < 8; ++g) val = lane == g ? ga[g] : val;
                IFG[(size_t)m * 8 + lane] = val + bif[lane]; }
            if (shout) {
#pragma unroll
                for (int j = 0; j < 4; ++j) ((f32x4*)shout)[lane + 64 * j] = v[j]; }
        }
#pragma unroll
        for (int j = 0; j < 4; ++j) o8[64 * j] = (unsigned long long)pk2(v[j].x, v[j].y) | ((unsigned long long)pk2(v[j].z, v[j].w) << 32);
    }
}


__device__ __forceinline__ void lora_act_pass(const Args& A, int gtid, int nthr) {
    const bf16* PB = (const bf16*)(A.ws + WS_PB); bf16* ALG = (bf16*)((unsigned char*)A.out + OUT_ALG); const float* mu = A.in[I_MU] + 3072;
    for (int it = gtid; it < NTOK * 32; it += nthr) {
        const int m = it >> 5, j = it & 31;
        int prow;
        if (m < NP) { const int t = m % TP; prow = t == 0 ? -1 : m - 1; } else { const int i = m - NP; prow = (i & 7) == 0 ? NTOK + (i >> 3) : m - 1; }
        const v4u lc = *(const v4u*)(PB + (size_t)m * PBW + 3072 + 8 * j); v4u lp = (v4u){0u, 0u, 0u, 0u};
        if (prow >= 0) lp = *(const v4u*)(PB + (size_t)prow * PBW + 3072 + 8 * j);
        const f32x4 m0 = *(const f32x4*)(mu + 8 * j), m1 = *(const f32x4*)(mu + 8 * j + 4); float ev[8];
        ev[0] = bflo(lc.x) + (bflo(lp.x) - bflo(lc.x)) * m0.x; ev[1] = bfhi(lc.x) + (bfhi(lp.x) - bfhi(lc.x)) * m0.y;
        ev[2] = bflo(lc.y) + (bflo(lp.y) - bflo(lc.y)) * m0.z; ev[3] = bfhi(lc.y) + (bfhi(lp.y) - bfhi(lc.y)) * m0.w;
        ev[4] = bflo(lc.z) + (bflo(lp.z) - bflo(lc.z)) * m1.x; ev[5] = bfhi(lc.z) + (bfhi(lp.z) - bfhi(lc.z)) * m1.y;
        ev[6] = bflo(lc.w) + (bflo(lp.w) - bflo(lc.w)) * m1.z; ev[7] = bfhi(lc.w) + (bfhi(lp.w) - bfhi(lc.w)) * m1.w;
        if (j < 8) {
#pragma unroll
            for (int i = 0; i < 8; ++i) ev[i] = tanhf_(ev[i]); }
        else if (j >= 16) {
#pragma unroll
            for (int i = 0; i < 8; ++i) ev[i] = sigmoidf_(ev[i]); }
        v4u o; o.x = pk2(ev[0], ev[1]); o.y = pk2(ev[2], ev[3]); o.z = pk2(ev[4], ev[5]); o.w = pk2(ev[6], ev[7]);
        *(v4u*)(ALG + (size_t)m * 256 + 8 * j) = o;
    }
}
constexpr int RW_RAWR = 0;
constexpr int RW_AL = 6656;
constexpr int RW_AA = RW_AL + 16 * 264 * 2;
constexpr int RW_EP = RW_AA + 16 * 68 * 4;
constexpr int RW_EN = RW_EP + 16 * 68 * 4;
constexpr int RW_RF = RW_EN + 16 * 68 * 4;
constexpr int RW_KF = RW_RF + 4096;
constexpr int RW_CD = RW_KF + 4096;
constexpr int R64 = 72, R32 = 40;
constexpr int RW_YF = RW_CD + 16 * R32 * 2;
constexpr int RW_VEC = RW_YF + 16 * 68 * 4;
constexpr int VC_NB = 256, VC_AKT = VC_NB + 16 * 72 * 2, VC_AN2 = VC_AKT + 64 * 40 * 2, VC_CDN = VC_AN2 + 1024;
constexpr int RW_VEC_SZ = VC_CDN + 16 * 40 * 2;
constexpr int RW_TRI = RW_VEC + 2 * RW_VEC_SZ;
constexpr int TR_G = 4096, TR_BON = 8192, TR_RB = 8256, TR_AB = TR_RB + 2304, TR_KB = TR_AB + 2304, TR_UVT = TR_KB + 2304;
constexpr int RW_TRI_SZ = TR_UVT + 64 * 40 * 2;
constexpr int RW_S0 = RW_TRI + 3 * RW_TRI_SZ;
constexpr int S0_SZ = 64 * 72 * 2;
constexpr int RW_S0L = RW_S0 + 2 * S0_SZ;
constexpr int RW_WT = RW_S0L + S0_SZ;
constexpr int RW_END = RW_WT + 64 * 20 * 4;
static_assert(RW_AL % 16 == 0 && RW_AA % 16 == 0 && RW_CD % 16 == 0 && RW_VEC % 16 == 0 && RW_VEC_SZ % 16 == 0 && RW_TRI % 16 == 0 && RW_TRI_SZ % 16 == 0 && RW_S0 % 16 == 0 && RW_END <= LDS_CTL, "rwkv lds");
__device__ __forceinline__ float frcp(float x) { return __builtin_amdgcn_rcpf(x); }
__device__ __forceinline__ float fsigm(float x) { return frcp(1.f + __expf(-x)); }
__device__ __forceinline__ float ftanh(float x) { return 1.f - 2.f * frcp(__expf(2.f * x) + 1.f); }
#define RW_BAR() do { asm volatile("s_waitcnt lgkmcnt(0)" ::: "memory"); __builtin_amdgcn_s_barrier(); asm volatile("" ::: "memory"); } while (0)

template <bool PROMPT> __device__ __forceinline__ void rwkv_item(const Args& A, LAS unsigned char* lds, int b0, int nseq, int h, int tid, int wid, int lane, bool dostore = true) {
    const bf16* PB = (const bf16*)(A.ws + WS_PB); const bf16* ALG = (const bf16*)((const unsigned char*)A.out + OUT_ALG);
    bf16* HB = (bf16*)(A.ws + WS_PB);
    constexpr int T = PROMPT ? TP : TS, NST = PROMPT ? 16 : 8, NCH = (T + 15) / 16, SPB = NST / 4;
    const int NE = nseq * NCH;
    if (wid < 4) {
        const int fr = lane & 15, fq = lane >> 4, w = wid;
        const int sv = tid >> 2, sj = tid & 3;
        const int stok = tid >> 4, scq = tid & 15, sch4 = 64 * h + 4 * scq;
        const f32x4 slxg4 = *(const f32x4*)(A.in[I_LXG] + sch4), slxb4 = *(const f32x4*)(A.in[I_LXB] + sch4);
        LAS bf16* CD = (LAS bf16*)(lds + RW_CD); LAS float* YF = (LAS float*)(lds + RW_YF);
        f32x4 accS[4], sx[4], sy[4];
#pragma unroll
        for (int j = 0; j < 4; ++j) sx[j] = (f32x4){0.f, 0.f, 0.f, 0.f};
        auto load_state = [&](int b) { const float* sp = A.in[I_RS] + (size_t)(b * 16 + h) * 4096;
#pragma unroll
            for (int kt = 0; kt < 4; ++kt)
#pragma unroll
                for (int r = 0; r < 4; ++r) sx[kt][r] = sp[(16 * w + 4 * fq + r) * 64 + 16 * kt + fr]; };
        if (!PROMPT) load_state(b0);
#pragma unroll
        for (int j = 0; j < 4; ++j) sy[j] = sx[j];
        for (int i = -1; i <= NE; ++i) {
            if (i >= 0 && i < NE) {
                const int sq = i / NCH, c = i - sq * NCH, b = b0 + sq;
                if (c == 0) {
#pragma unroll
                    for (int j = 0; j < 4; ++j) accS[j] = sy[j];
                    if (!PROMPT && sq + 1 < nseq) load_state(b + 1);
                }
                const LAS unsigned char* vc = lds + RW_VEC + (i & 1) * RW_VEC_SZ; const LAS float* PWv = (const LAS float*)vc; const LAS bf16* NB = (const LAS bf16*)(vc + VC_NB);
                const LAS bf16* AKT = (const LAS bf16*)(vc + VC_AKT); const LAS float* AN2 = (const LAS float*)(vc + VC_AN2); const LAS bf16* CDN = (const LAS bf16*)(vc + VC_CDN);
                LAS bf16* UVT = (LAS bf16*)(lds + RW_TRI + (i % 3) * RW_TRI_SZ + TR_UVT);
                LAS bf16* S0h = (LAS bf16*)(lds + RW_S0 + (i & 1) * S0_SZ); LAS bf16* S0l = (LAS bf16*)(lds + RW_S0L); LAS float* WT = (LAS float*)(lds + RW_WT);
                const int ep = i - 1; const LAS unsigned char* trp = lds + RW_TRI + ((ep < 0 ? 0 : ep) % 3) * RW_TRI_SZ;
                if (i >= 1 && w < 2) {
                    const LAS bf16* Xb = (const LAS bf16*)(trp + (w == 0 ? TR_AB : TR_KB)); const LAS bf16* Rb = (const LAS bf16*)(trp + TR_RB);
                    f32x4 d = (f32x4){0.f, 0.f, 0.f, 0.f};
#pragma unroll
                    for (int ks = 0; ks < 2; ++ks) d = __builtin_amdgcn_mfma_f32_16x16x32_bf16(*(const LAS bf16x8*)(Xb + fr * R64 + 32 * ks + 8 * fq), *(const LAS bf16x8*)(Rb + fr * R64 + 32 * ks + 8 * fq), d, 0, 0, 0);
                    v2u cw; cw.x = pk2(4 * fq + 0 <= fr ? d[0] : 0.f, 4 * fq + 1 <= fr ? d[1] : 0.f); cw.y = pk2(4 * fq + 2 <= fr ? d[2] : 0.f, 4 * fq + 3 <= fr ? d[3] : 0.f);
                    *(LAS v2u*)(CD + fr * R32 + 16 * w + 4 * fq) = cw;
                }
                if (w >= 2) {
                    const LAS bf16* Xb = (const LAS bf16*)(lds + RW_TRI + (i % 3) * RW_TRI_SZ + ((w == 2) ? TR_AB : TR_KB)); LAS float* AN2w = (LAS float*)(lds + RW_VEC + (i & 1) * RW_VEC_SZ + VC_AN2); LAS bf16* CDNw = (LAS bf16*)(lds + RW_VEC + (i & 1) * RW_VEC_SZ + VC_CDN);
                    f32x4 d = (f32x4){0.f, 0.f, 0.f, 0.f};
#pragma unroll
                    for (int ks = 0; ks < 2; ++ks) d = __builtin_amdgcn_mfma_f32_16x16x32_bf16(*(const LAS bf16x8*)(Xb + fr * R64 + 32 * ks + 8 * fq), *(const LAS bf16x8*)(NB + fr * R64 + 32 * ks + 8 * fq), d, 0, 0, 0);
                    if (w == 2) {
#pragma unroll
                        for (int r = 0; r < 4; ++r) AN2w[(fr * 4 + r) * 4 + fq] = (4 * fq + r < fr) ? d[r] : 0.f;
                    } else {
                        v2u wz; wz.x = 0u; wz.y = 0u; *(LAS v2u*)(CDNw + fr * R32 + 4 * fq) = wz;
                        v2u cw2; cw2.x = pk2(4 * fq + 0 < fr ? d[0] : 0.f, 4 * fq + 1 < fr ? d[1] : 0.f); cw2.y = pk2(4 * fq + 2 < fr ? d[2] : 0.f, 4 * fq + 3 < fr ? d[3] : 0.f);
                        *(LAS v2u*)(CDNw + fr * R32 + 16 + 4 * fq) = cw2;
                    }
                }
#pragma unroll
                for (int kt = 0; kt < 4; ++kt)
#pragma unroll
                    for (int r = 0; r < 4; r += 2) {
                        const float x0 = accS[kt][r], x1 = accS[kt][r + 1]; const unsigned hi2 = pk2(x0, x1); const unsigned lo2 = pk2(x0 - bflo(hi2), x1 - bfhi(hi2));
                        const int o = (16 * w + 4 * fq + r) * R64 + 16 * kt + fr;
                        S0h[o] = (bf16)(hi2 & 0xffffu); S0h[o + R64] = (bf16)(hi2 >> 16); S0l[o] = (bf16)(lo2 & 0xffffu); S0l[o + R64] = (bf16)(lo2 >> 16); }
                RW_BAR();
                if (i >= 1) {
                    const LAS bf16* Rb = (const LAS bf16*)(trp + TR_RB); const LAS bf16* S0 = (const LAS bf16*)(lds + RW_S0 + (ep & 1) * S0_SZ); const LAS bf16* UVp = (const LAS bf16*)(trp + TR_UVT);
                    f32x4 d = (f32x4){0.f, 0.f, 0.f, 0.f};
#pragma unroll
                    for (int ks = 0; ks < 2; ++ks) d = __builtin_amdgcn_mfma_f32_16x16x32_bf16(*(const LAS bf16x8*)(Rb + fr * R64 + 32 * ks + 8 * fq), *(const LAS bf16x8*)(S0 + (16 * w + fr) * R64 + 32 * ks + 8 * fq), d, 0, 0, 0);
                    d = __builtin_amdgcn_mfma_f32_16x16x32_bf16(*(const LAS bf16x8*)(CD + fr * R32 + 8 * fq), *(const LAS bf16x8*)(UVp + (16 * w + fr) * R32 + 8 * (fq ^ (fr >> 2))), d, 0, 0, 0);
#pragma unroll
                    for (int r = 0; r < 4; ++r) YF[(4 * fq + r) * 68 + 16 * w + fr] = d[r];
                }
                {
                    f32x4 d = (f32x4){0.f, 0.f, 0.f, 0.f};
#pragma unroll
                    for (int ks = 0; ks < 2; ++ks) { const bf16x8 a = *(const LAS bf16x8*)(NB + fr * R64 + 32 * ks + 8 * fq);
                        d = __builtin_amdgcn_mfma_f32_16x16x32_bf16(a, *(const LAS bf16x8*)(S0h + (16 * w + fr) * R64 + 32 * ks + 8 * fq), d, 0, 0, 0);
                        d = __builtin_amdgcn_mfma_f32_16x16x32_bf16(a, *(const LAS bf16x8*)(S0l + (16 * w + fr) * R64 + 32 * ks + 8 * fq), d, 0, 0, 0); }
                    d = __builtin_amdgcn_mfma_f32_16x16x32_bf16(*(const LAS bf16x8*)(CDN + fr * R32 + 8 * fq), *(const LAS bf16x8*)(UVT + (16 * w + fr) * R32 + 8 * (fq ^ (fr >> 2))), d, 0, 0, 0);
                    *(LAS f32x4*)(WT + (16 * w + fr) * 20 + 4 * fq) = d;
                }
                RW_BAR();
                {
                    const f32x4 w0 = *(const LAS f32x4*)(WT + sv * 20), w1 = *(const LAS f32x4*)(WT + sv * 20 + 4), w2 = *(const LAS f32x4*)(WT + sv * 20 + 8), w3 = *(const LAS f32x4*)(WT + sv * 20 + 12);
                    const float wv[16] = {w0.x, w0.y, w0.z, w0.w, w1.x, w1.y, w1.z, w1.w, w2.x, w2.y, w2.z, w2.w, w3.x, w3.y, w3.z, w3.w};
                    float u[4] = {0.f, 0.f, 0.f, 0.f};
#pragma unroll
                    for (int t = 0; t < 16; ++t) {
                        const f32x4 cf = *(const LAS f32x4*)(AN2 + (t * 4 + sj) * 4);
                        float p = (u[0] * cf.x + u[1] * cf.y) + (u[2] * cf.z + u[3] * cf.w);
                        p += dppf<0xB1>(p); p += dppf<0x4E>(p);
                        const float ut = wv[t] + p;
                        if (sj == (t & 3)) u[t >> 2] = ut;
                    }
#pragma unroll
                    for (int m2 = 0; m2 < 4; ++m2) { const int ii = 4 * m2 + sj; UVT[sv * R32 + 8 * ((ii >> 3) ^ ((sv >> 2) & 3)) + (ii & 7)] = (bf16)(pk2(u[m2], u[m2]) & 0xffffu); }
                }
                RW_BAR();
                if (i >= 1 && stok < NST) {
                    const int sq = ep / NCH, c = ep - sq * NCH, b = b0 + sq; const int row0 = PROMPT ? b * TP : NP + b * TS;
                    const int o = stok * 64 + 4 * scq; const f32x4 y4 = *(const LAS f32x4*)(YF + stok * 68 + 4 * scq);
                    const float mean = red16((y4.x + y4.y) + (y4.z + y4.w)) * (1.f / 64.f); const f32x4 d = y4 - mean;
                    const float var = red16((d.x * d.x + d.y * d.y) + (d.z * d.z + d.w * d.w)) * (1.f / 64.f); const float rstd = __builtin_amdgcn_rsqf(var + GN_EPS_B);
                    const f32x4 v4 = *(const LAS f32x4*)((const LAS float*)trp + o), g4 = *(const LAS f32x4*)((const LAS float*)(trp + TR_G) + o); const float bon = ((const LAS float*)(trp + TR_BON))[stok];
                    const f32x4 ov = (d * rstd * slxg4 + slxb4 + bon * v4) * g4;
                    v2u w; w.x = pk2(ov.x, ov.y); w.y = pk2(ov.z, ov.w);
                    if (dostore) *(v2u*)(HB + (size_t)(row0 + 16 * c + stok) * PBW + sch4) = w;
                }
#pragma unroll
                for (int kt = 0; kt < 4; ++kt) {
                    f32x4 d = __builtin_amdgcn_mfma_f32_16x16x32_bf16(*(const LAS bf16x8*)(UVT + (16 * w + fr) * R32 + 8 * (fq ^ (fr >> 2))), *(const LAS bf16x8*)(AKT + (16 * kt + fr) * R32 + 8 * (fq ^ (fr >> 2))), accS[kt], 0, 0, 0);
                    accS[kt] = d * PWv[16 * kt + fr];
                }
                if (c == NCH - 1) {
#pragma unroll
                    for (int j = 0; j < 4; ++j) sy[j] = sx[j];
                    asm volatile("" : "+v"(sy[0]), "+v"(sy[1]), "+v"(sy[2]), "+v"(sy[3]));
                    float* so = A.out + (PROMPT ? O_PS : O_SS) + (size_t)(b * 16 + h) * 4096;
#pragma unroll
                    for (int kt = 0; kt < 4; ++kt)
#pragma unroll
                        for (int r = 0; r < 4; ++r) so[(16 * w + 4 * fq + r) * 64 + 16 * kt + fr] = accS[kt][r];
                }
                RW_BAR();
            } else {
                const int ep = i - 1; const LAS unsigned char* trp = lds + RW_TRI + ((ep < 0 ? 0 : ep) % 3) * RW_TRI_SZ;
                if (i >= 1 && w < 2) {
                    const LAS bf16* Xb = (const LAS bf16*)(trp + (w == 0 ? TR_AB : TR_KB)); const LAS bf16* Rb = (const LAS bf16*)(trp + TR_RB);
                    f32x4 d = (f32x4){0.f, 0.f, 0.f, 0.f};
#pragma unroll
                    for (int ks = 0; ks < 2; ++ks) d = __builtin_amdgcn_mfma_f32_16x16x32_bf16(*(const LAS bf16x8*)(Xb + fr * R64 + 32 * ks + 8 * fq), *(const LAS bf16x8*)(Rb + fr * R64 + 32 * ks + 8 * fq), d, 0, 0, 0);
                    v2u cw; cw.x = pk2(4 * fq + 0 <= fr ? d[0] : 0.f, 4 * fq + 1 <= fr ? d[1] : 0.f); cw.y = pk2(4 * fq + 2 <= fr ? d[2] : 0.f, 4 * fq + 3 <= fr ? d[3] : 0.f);
                    *(LAS v2u*)(CD + fr * R32 + 16 * w + 4 * fq) = cw;
                }
                RW_BAR();
                if (i >= 1) {
                    const LAS bf16* Rb = (const LAS bf16*)(trp + TR_RB); const LAS bf16* S0 = (const LAS bf16*)(lds + RW_S0 + (ep & 1) * S0_SZ); const LAS bf16* UVp = (const LAS bf16*)(trp + TR_UVT);
                    f32x4 d = (f32x4){0.f, 0.f, 0.f, 0.f};
#pragma unroll
                    for (int ks = 0; ks < 2; ++ks) d = __builtin_amdgcn_mfma_f32_16x16x32_bf16(*(const LAS bf16x8*)(Rb + fr * R64 + 32 * ks + 8 * fq), *(const LAS bf16x8*)(S0 + (16 * w + fr) * R64 + 32 * ks + 8 * fq), d, 0, 0, 0);
                    d = __builtin_amdgcn_mfma_f32_16x16x32_bf16(*(const LAS bf16x8*)(CD + fr * R32 + 8 * fq), *(const LAS bf16x8*)(UVp + (16 * w + fr) * R32 + 8 * (fq ^ (fr >> 2))), d, 0, 0, 0);
#pragma unroll
                    for (int r = 0; r < 4; ++r) YF[(4 * fq + r) * 68 + 16 * w + fr] = d[r];
                }
                RW_BAR(); RW_BAR();
                if (i >= 1 && stok < NST) {
                    const int sq = ep / NCH, c = ep - sq * NCH, b = b0 + sq; const int row0 = PROMPT ? b * TP : NP + b * TS;
                    const int o = stok * 64 + 4 * scq; const f32x4 y4 = *(const LAS f32x4*)(YF + stok * 68 + 4 * scq);
                    const float mean = red16((y4.x + y4.y) + (y4.z + y4.w)) * (1.f / 64.f); const f32x4 d = y4 - mean;
                    const float var = red16((d.x * d.x + d.y * d.y) + (d.z * d.z + d.w * d.w)) * (1.f / 64.f); const float rstd = __builtin_amdgcn_rsqf(var + GN_EPS_B);
                    const f32x4 v4 = *(const LAS f32x4*)((const LAS float*)trp + o), g4 = *(const LAS f32x4*)((const LAS float*)(trp + TR_G) + o); const float bon = ((const LAS float*)(trp + TR_BON))[stok];
                    const f32x4 ov = (d * rstd * slxg4 + slxb4 + bon * v4) * g4;
                    v2u w; w.x = pk2(ov.x, ov.y); w.y = pk2(ov.z, ov.w);
                    if (dostore) *(v2u*)(HB + (size_t)(row0 + 16 * c + stok) * PBW + sch4) = w;
                }
                RW_BAR();
            }
        }
    } else {
        const int p = tid - 256, pw = wid - 4, fr = lane & 15, fq = lane >> 4;
        const int tok = p >> 4, cq = p & 15;
        LAS bf16* rawr = (LAS bf16*)(lds + RW_RAWR); LAS bf16* AL = (LAS bf16*)(lds + RW_AL); LAS float* Aa = (LAS float*)(lds + RW_AA); LAS float* EP = (LAS float*)(lds + RW_EP); LAS float* EN = (LAS float*)(lds + RW_EN);
        LAS float* Rr = (LAS float*)(lds + RW_RF); LAS bf16* CD = (LAS bf16*)(lds + RW_CD); LAS float* YF = (LAS float*)(lds + RW_YF);
        const int ch4 = 64 * h + 4 * cq;
        const f32x4 kks4 = *(const f32x4*)(A.in[I_KKS] + ch4), kas4 = *(const f32x4*)(A.in[I_KAS] + ch4), rk4 = *(const f32x4*)(A.in[I_RK] + ch4);
        const f32x4 lxg4 = *(const f32x4*)(A.in[I_LXG] + ch4), lxb4 = *(const f32x4*)(A.in[I_LXB] + ch4);
        const f32x4 mur = *(const f32x4*)(A.in[I_MU] + ch4), muk = *(const f32x4*)(A.in[I_MU] + 1024 + ch4), muv = *(const f32x4*)(A.in[I_MU] + 2048 + ch4);
        const int chm = 64 * h + 16 * pw + fr;
        const float w0c = A.in[I_W0][chm], a0c = A.in[I_A0][chm];
        bf16x8 bw[8];
        {
            const float* w2 = A.in[I_W2]; const float* a2 = A.in[I_A2]; const float* g2 = A.in[I_G2];
#pragma unroll
            for (int s = 0; s < 8; ++s) {
                const float* src = s < 2 ? w2 + (size_t)(32 * s + 8 * fq) * 1024 + chm : (s < 4 ? a2 + (size_t)(32 * (s - 2) + 8 * fq) * 1024 + chm : g2 + (size_t)(32 * (s - 4) + 8 * fq) * 1024 + chm);
#pragma unroll
                for (int j = 0; j < 8; ++j) bw[s][j] = (short)f2bf(src[(size_t)j * 1024]);
            }
        }
        v4u pfr0, pfr1, pfl0, pfl1; bf16 ppv0 = 0;
        const int q0 = p, q1 = p + 256;
        const int t0r = q0 / 24, rem0 = q0 - t0r * 24, t1r = q1 / 24, rem1 = q1 - t1r * 24;
        auto prefetch = [&](int e) {
            const int sq = e / NCH, c = e - sq * NCH, b = b0 + sq; const int row0 = PROMPT ? b * TP : NP + b * TS; const int tb = 16 * c;
            pfr0 = (v4u){0u, 0u, 0u, 0u}; pfr1 = pfr0; pfl0 = pfr0; pfl1 = pfr0;
            if (tb + t0r < T) pfr0 = *(const v4u*)(PB + (size_t)(row0 + tb + t0r) * PBW + (rem0 >> 3) * 1024 + 64 * h + (rem0 & 7) * 8);
            if (q1 < 384 && tb + t1r < T) pfr1 = *(const v4u*)(PB + (size_t)(row0 + tb + t1r) * PBW + (rem1 >> 3) * 1024 + 64 * h + (rem1 & 7) * 8);
            if (tb + (p >> 5) < T) pfl0 = *(const v4u*)(ALG + (size_t)(row0 + tb + (p >> 5)) * 256 + (p & 31) * 8);
            if (tb + 8 + (p >> 5) < T) pfl1 = *(const v4u*)(ALG + (size_t)(row0 + tb + 8 + (p >> 5)) * 256 + (p & 31) * 8);
            if (!PROMPT && c == 0) { const bf16* prow = PB + (size_t)(NTOK + b) * PBW;
                if (p < 192) ppv0 = prow[(p >> 6) * 1024 + 64 * h + (p & 63)]; }
        };
        prefetch(0);
#pragma unroll
        for (int z = 0; z < 3; ++z) { LAS v4u* zp = (LAS v4u*)(lds + RW_TRI + z * RW_TRI_SZ + TR_UVT); zp[p] = (v4u){0u, 0u, 0u, 0u}; if (p < 64) zp[256 + p] = (v4u){0u, 0u, 0u, 0u}; }
        for (int i = -1; i <= NE; ++i) {
            const int e = i + 1; const bool doprep = e < NE;
            LAS unsigned char* vcb = lds + RW_VEC + (e & 1) * RW_VEC_SZ; LAS float* PWv = (LAS float*)vcb; LAS bf16* NB = (LAS bf16*)(vcb + VC_NB); LAS bf16* AKT = (LAS bf16*)(vcb + VC_AKT);
            LAS float* AN2 = (LAS float*)(vcb + VC_AN2); LAS bf16* CDN = (LAS bf16*)(vcb + VC_CDN); LAS float* Kp = (LAS float*)(lds + RW_KF);
            LAS unsigned char* trb = lds + RW_TRI + (e % 3) * RW_TRI_SZ; LAS float* Vv = (LAS float*)trb; LAS float* Gg = (LAS float*)(trb + TR_G); LAS float* BON = (LAS float*)(trb + TR_BON);
            LAS bf16* RB = (LAS bf16*)(trb + TR_RB); LAS bf16* AB = (LAS bf16*)(trb + TR_AB); LAS bf16* KB = (LAS bf16*)(trb + TR_KB); LAS bf16* UVT = (LAS bf16*)(trb + TR_UVT);
            const int ep = i - 1;
            const LAS unsigned char* trp = lds + RW_TRI + ((ep < 0 ? 0 : ep) % 3) * RW_TRI_SZ;
#define RW_REGS_TO_LDS(ee) do { \
                *(LAS v4u*)(rawr + (t0r + 1) * 192 + (rem0 >> 3) * 64 + (rem0 & 7) * 8) = pfr0; \
                if (q1 < 384) *(LAS v4u*)(rawr + (t1r + 1) * 192 + (rem1 >> 3) * 64 + (rem1 & 7) * 8) = pfr1; \
                *(LAS v4u*)(AL + (p >> 5) * 264 + (p & 31) * 8) = pfl0; *(LAS v4u*)(AL + ((p >> 5) + 8) * 264 + (p & 31) * 8) = pfl1; \
                if ((ee) % NCH == 0) { if (p < 192) rawr[p] = PROMPT ? (bf16)0 : ppv0; } } while (0)
            if (doprep) {
                RW_REGS_TO_LDS(e);
                if (e + 1 < NE) prefetch(e + 1);
            }
            RW_BAR();
            if (doprep) {
                const LAS v2u* rc = (const LAS v2u*)(rawr + (tok + 1) * 192 + 4 * cq); const LAS v2u* rp = (const LAS v2u*)(rawr + tok * 192 + 4 * cq);
                const v2u c0 = rc[0], c1 = rc[16], c2 = rc[32], p0 = rp[0], p1 = rp[16], p2 = rp[32];
                f32x4 x;
                x.x = bflo(c0.x) + (bflo(p0.x) - bflo(c0.x)) * mur.x; x.y = bfhi(c0.x) + (bfhi(p0.x) - bfhi(c0.x)) * mur.y; x.z = bflo(c0.y) + (bflo(p0.y) - bflo(c0.y)) * mur.z; x.w = bfhi(c0.y) + (bfhi(p0.y) - bfhi(c0.y)) * mur.w;
                *(LAS f32x4*)(Rr + tok * 64 + 4 * cq) = x;
                x.x = bflo(c1.x) + (bflo(p1.x) - bflo(c1.x)) * muk.x; x.y = bfhi(c1.x) + (bfhi(p1.x) - bfhi(c1.x)) * muk.y; x.z = bflo(c1.y) + (bflo(p1.y) - bflo(c1.y)) * muk.z; x.w = bfhi(c1.y) + (bfhi(p1.y) - bfhi(c1.y)) * muk.w;
                *(LAS f32x4*)(Kp + tok * 64 + 4 * cq) = x;
                x.x = bflo(c2.x) + (bflo(p2.x) - bflo(c2.x)) * muv.x; x.y = bfhi(c2.x) + (bfhi(p2.x) - bfhi(c2.x)) * muv.y; x.z = bflo(c2.y) + (bflo(p2.y) - bflo(c2.y)) * muv.z; x.w = bfhi(c2.y) + (bfhi(p2.y) - bfhi(c2.y)) * muv.w;
                *(LAS f32x4*)(Vv + tok * 64 + 4 * cq) = x;
                { const unsigned v01 = pk2(x.x, x.y), v23 = pk2(x.z, x.w); LAS bf16* vt = UVT + (4 * cq) * R32 + 8 * ((2 + (tok >> 3)) ^ (cq & 3)) + (tok & 7);
                  vt[0] = (bf16)(v01 & 0xffffu); vt[R32] = (bf16)(v01 >> 16); vt[2 * R32] = (bf16)(v23 & 0xffffu); vt[3 * R32] = (bf16)(v23 >> 16); }
            }
            RW_BAR();
            if (doprep) {
                if (PROMPT) { if (p < 192) rawr[p] = rawr[16 * 192 + p]; }
                f32x4 d0 = (f32x4){0.f, 0.f, 0.f, 0.f}, d1 = d0, d2 = d0;
                const LAS bf16* ar = AL + fr * 264 + 8 * fq;
#pragma unroll
                for (int s = 0; s < 2; ++s) { d0 = __builtin_amdgcn_mfma_f32_16x16x32_bf16(*(const LAS bf16x8*)(ar + 32 * s), bw[s], d0, 0, 0, 0);
                                              d1 = __builtin_amdgcn_mfma_f32_16x16x32_bf16(*(const LAS bf16x8*)(ar + 64 + 32 * s), bw[2 + s], d1, 0, 0, 0); }
#pragma unroll
                for (int s = 0; s < 4; ++s) d2 = __builtin_amdgcn_mfma_f32_16x16x32_bf16(*(const LAS bf16x8*)(ar + 128 + 32 * s), bw[4 + s], d2, 0, 0, 0);
                float lw[4];
#pragma unroll
                for (int r = 0; r < 4; ++r) lw[r] = -0.6065306597126334f * fsigm(w0c + d0[r]);
                lw[1] += lw[0]; lw[2] += lw[1]; lw[3] += lw[2];
                { const float t4 = lw[3]; const float x1 = __shfl_up(t4, 16), x2 = __shfl_up(t4, 32), x3 = __shfl_up(t4, 48);
                  const float base = (fq >= 1 ? x1 : 0.f) + (fq >= 2 ? x2 : 0.f) + (fq >= 3 ? x3 : 0.f);
#pragma unroll
                  for (int r = 0; r < 4; ++r) lw[r] += base; }
#pragma unroll
                for (int r = 0; r < 4; ++r) { const int o = (4 * fq + r) * 64 + 16 * pw + fr;
                    const int oe = (4 * fq + r) * 68 + 16 * pw + fr;
                    EP[oe] = __expf(lw[r]); EN[oe] = __expf(-lw[r]); Aa[oe] = fsigm(a0c + d1[r]); Gg[o] = d2[r]; }
            }
            RW_BAR();
            if (doprep) {
                const int o = tok * 64 + 4 * cq, ob = tok * R64 + 4 * cq;
                const int oe = tok * 68 + 4 * cq; const f32x4 k4 = *(const LAS f32x4*)(Kp + o), a4 = *(const LAS f32x4*)(Aa + oe), r4 = *(const LAS f32x4*)(Rr + o);
                f32x4 kk = k4 * kks4; const float ss = red16((kk.x * kk.x + kk.y * kk.y) + (kk.z * kk.z + kk.w * kk.w)); kk = kk * __builtin_amdgcn_rsqf(fmaxf(ss, 1e-24f));
                const f32x4 kp = k4 * (1.f + (a4 - 1.f) * kas4);
                const f32x4 ep = *(const LAS f32x4*)(EP + oe), en = *(const LAS f32x4*)(EN + oe);
                f32x4 epp = (f32x4){1.f, 1.f, 1.f, 1.f}; if (tok > 0) epp = *(const LAS f32x4*)(EP + oe - 68);
                const f32x4 kat = kk * a4 * en, kpt = kp * en, rt = r4 * ep;
                { const f32x4 nn = -kk * epp; v2u w; w.x = pk2(nn.x, nn.y); w.y = pk2(nn.z, nn.w); *(LAS v2u*)(NB + ob) = w; }
                {
                    const bool real = tok < NST; const unsigned a01 = real ? pk2(kat.x, kat.y) : 0u, a23 = real ? pk2(kat.z, kat.w) : 0u, k01 = real ? pk2(kpt.x, kpt.y) : 0u, k23 = real ? pk2(kpt.z, kpt.w) : 0u;
                    LAS bf16* at = AKT + (4 * cq) * R32 + 8 * ((tok >> 3) ^ (cq & 3)) + (tok & 7); const int ak = 8 * ((2 + (tok >> 3)) ^ (cq & 3)) - 8 * ((tok >> 3) ^ (cq & 3));
                    at[0] = (bf16)(a01 & 0xffffu); at[R32] = (bf16)(a01 >> 16); at[2 * R32] = (bf16)(a23 & 0xffffu); at[3 * R32] = (bf16)(a23 >> 16);
                    at[ak] = (bf16)(k01 & 0xffffu); at[R32 + ak] = (bf16)(k01 >> 16); at[2 * R32 + ak] = (bf16)(k23 & 0xffffu); at[3 * R32 + ak] = (bf16)(k23 >> 16);
                }
                { v2u w; w.x = pk2(rt.x, rt.y); w.y = pk2(rt.z, rt.w); *(LAS v2u*)(RB + ob) = w; w.x = pk2(kat.x, kat.y); w.y = pk2(kat.z, kat.w); *(LAS v2u*)(AB + ob) = w; w.x = pk2(kpt.x, kpt.y); w.y = pk2(kpt.z, kpt.w); *(LAS v2u*)(KB + ob) = w; }
                if (tok == NST - 1) *(LAS f32x4*)(PWv + 4 * cq) = ep;
                const f32x4 rb = r4 * kp * rk4; const float bon = red16((rb.x + rb.y) + (rb.z + rb.w)); if (cq == 0) BON[tok] = bon;
            }
            RW_BAR();
        }
    }
    __syncthreads();
}

constexpr int ML_Q = 0;
constexpr int ML_K = ML_Q + 64 * 136 * 2;
constexpr int ML_KT = ML_K + 64 * 136 * 2;
constexpr int ML_VT = ML_KT + 128 * 72 * 2;
constexpr int ML_S = ML_VT + 64 * 72 * 2;
constexpr int ML_CT = ML_S + 64 * 72 * 2;
constexpr int ML_F = ML_CT + 64 * 136 * 2;
constexpr int ML_END = ML_F + (7 * 64 + 128) * 4;
static_assert(ML_K % 16 == 0 && ML_KT % 16 == 0 && ML_VT % 16 == 0 && ML_S % 16 == 0 && ML_CT % 16 == 0 && ML_F % 16 == 0 && ML_END <= LDS_CTL, "mlstm lds");

__device__ __forceinline__ void mlstm_item(const Args& A, LAS unsigned char* lds, bool prompt, int b0, int nseq, int h, int sl, int tid, int wid, int lane) {
    bf16* QKV = (bf16*)(A.ws + WS_QKV); const float* IFG = (const float*)(A.ws + WS_IFG);
    const int nch = prompt ? 33 : 1; const int nv0 = prompt ? 16 : 8;
    LAS bf16* Qs = (LAS bf16*)(lds + ML_Q); LAS bf16* Ks = (LAS bf16*)(lds + ML_K); LAS bf16* KT = (LAS bf16*)(lds + ML_KT); LAS bf16* VT = (LAS bf16*)(lds + ML_VT);
    LAS bf16* Ss = (LAS bf16*)(lds + ML_S); LAS bf16* CT = (LAS bf16*)(lds + ML_CT);
    LAS float* AS = (LAS float*)(lds + ML_F); LAS float* MX = AS + 64; LAS float* WINT = AS + 128; LAS float* EMR = AS + 192; LAS float* WK = AS + 256; LAS float* DEN1 = AS + 320; LAS float* DEN2 = AS + 384; LAS float* NV = AS + 448;
    const int fr = lane & 15, fq = lane >> 4;
    const int tm = wid >> 1, tn0 = (wid & 1) * 2;
    const float NEG_INF = -__builtin_inff();
    const int qk_tok0 = tid >> 4, qk_part = tid & 15, v_tok = tid >> 3, v_part = tid & 7;
    v4u pq[2], pk[2], pv;
    auto load_tiles = [&](int row_t0, int nvalid) {
#pragma unroll
        for (int i = 0; i < 2; ++i) { const int tok = qk_tok0 + 32 * i;
            if (tok < nvalid) { const bf16* rp = QKV + (size_t)(row_t0 + tok) * 2048 + h * 128 + qk_part * 8; pq[i] = *(const v4u*)rp; pk[i] = *(const v4u*)(rp + 512); }
            else { pq[i] = (v4u){0u, 0u, 0u, 0u}; pk[i] = (v4u){0u, 0u, 0u, 0u}; } }
        if (v_tok < nvalid) pv = *(const v4u*)(QKV + (size_t)(row_t0 + v_tok) * 2048 + 1024 + h * 256 + sl * 64 + v_part * 8); else pv = (v4u){0u, 0u, 0u, 0u};
    };
    f32x4 pC[4]; float pnv = 0.f, pmm = 0.f;
#pragma unroll
    for (int tn = 0; tn < 4; ++tn) pC[tn] = (f32x4){0.f, 0.f, 0.f, 0.f};
    auto load_state = [&](int b) {
        const float* C0 = A.in[I_MC] + (size_t)(b * 4 + h) * 128 * 256 + sl * 64;
#pragma unroll
        for (int tn = 0; tn < 4; ++tn)
#pragma unroll
            for (int r = 0; r < 4; ++r) pC[tn][r] = C0[(size_t)(16 * wid + 4 * fq + r) * 256 + 16 * tn + fr];
        if (tid < 128) pnv = A.in[I_MN][(size_t)(b * 4 + h) * 128 + tid];
        pmm = A.in[I_MM][b * 4 + h];
    };
    float gli = NEG_INF, gfp = 0.f;
    { const int row0 = prompt ? b0 * TP : NP + b0 * TS;
      if (!prompt) load_state(b0);
      load_tiles(row0, nv0);
      if (wid == 0 && lane < nv0) { gli = IFG[(size_t)(row0 + lane) * 8 + h]; gfp = IFG[(size_t)(row0 + lane) * 8 + 4 + h]; } }
    f32x4 oC[4]; float onv = 0.f, omm = 0.f; int ob = -1;
    f32x4 accC[4]; float m_state = 0.f;
    for (int sq = 0; sq < nseq; ++sq) {
        const int b = b0 + sq; const int row0 = prompt ? b * TP : NP + b * TS;
        __syncthreads();
#pragma unroll
        for (int tn = 0; tn < 4; ++tn) accC[tn] = pC[tn];
        if (tid < 128) NV[tid] = pnv;
        m_state = pmm;
#pragma unroll
        for (int tn = 0; tn < 4; ++tn) { v2u w; w.x = pk2(accC[tn][0], accC[tn][1]); w.y = pk2(accC[tn][2], accC[tn][3]); *(LAS v2u*)(CT + (16 * tn + fr) * 136 + 16 * wid + 4 * fq) = w; }
        if (sq + 1 < nseq) load_state(b + 1);
        for (int c = 0; c < nch; ++c) {
            const int t0 = prompt ? (c == 0 ? 0 : 16 + 64 * (c - 1)) : 0; const int nvalid = prompt ? (c == 0 ? 16 : 64) : 8;
            RW_BAR();
            if (wid == 0) {
                const bool valid = lane < nvalid;
                float li = NEG_INF, lf = 0.f;
                if (valid) { li = gli; const float fp = gfp; lf = fminf(fp, 0.f) - __logf(1.f + __expf(-fabsf(fp))); }
                if (c + 1 < nch) { const size_t rn = (size_t)(row0 + 16 + 64 * c + lane); gli = IFG[rn * 8 + h]; gfp = IFG[rn * 8 + 4 + h]; }
                else if (sq + 1 < nseq) { gli = NEG_INF; gfp = 0.f; if (lane < nv0) { const size_t rn = (size_t)(row0 + TS + lane); gli = IFG[rn * 8 + h]; gfp = IFG[rn * 8 + 4 + h]; } }
                const float bsum = wave_scan_sum(lf);
                const float a = valid ? li - bsum : NEG_INF;
                const float pm = wave_scan_max(a);
                const float mx = fmaxf(m_state, pm);
                const float blast = __builtin_bit_cast(float, __builtin_amdgcn_readlane(__builtin_bit_cast(int, bsum), 63)), mx63 = __builtin_bit_cast(float, __builtin_amdgcn_readlane(__builtin_bit_cast(int, mx), 63));
                AS[lane] = a; MX[lane] = mx; WINT[lane] = __expf(m_state - mx); EMR[lane] = __expf(-(bsum + mx)); WK[lane] = __expf(a - mx63);
                m_state = blast + mx63;
            }
            RW_BAR();
            {
                const float ksc = 0.08838834764831845f;
#pragma unroll
                for (int i = 0; i < 2; ++i) { const int tok = qk_tok0 + 32 * i;
                    *(LAS v4u*)(Qs + tok * 136 + qk_part * 8) = pq[i];
                    const float wk = WK[tok]; const v4u kr = pk[i];
                    float kf[8] = {bflo(kr.x) * ksc, bfhi(kr.x) * ksc, bflo(kr.y) * ksc, bfhi(kr.y) * ksc, bflo(kr.z) * ksc, bfhi(kr.z) * ksc, bflo(kr.w) * ksc, bfhi(kr.w) * ksc};
                    v4u ko; ko.x = pk2(kf[0], kf[1]); ko.y = pk2(kf[2], kf[3]); ko.z = pk2(kf[4], kf[5]); ko.w = pk2(kf[6], kf[7]);
                    *(LAS v4u*)(Ks + tok * 136 + qk_part * 8) = ko;
#pragma unroll
                    for (int j = 0; j < 8; ++j) KT[(qk_part * 8 + j) * 72 + 8 * ((tok >> 3) ^ (qk_part & 7)) + (tok & 7)] = bf1(kf[j] * wk); }
                const unsigned vr[4] = {pv.x, pv.y, pv.z, pv.w};
#pragma unroll
                for (int j = 0; j < 4; ++j) { const int vc = 8 * ((v_tok >> 3) ^ v_part) + (v_tok & 7); VT[(v_part * 8 + 2 * j) * 72 + vc] = (bf16)(vr[j] & 0xffffu); VT[(v_part * 8 + 2 * j + 1) * 72 + vc] = (bf16)(vr[j] >> 16); }
            }
            if (c + 1 < nch) load_tiles(row0 + 16 + 64 * c, 64);
            else if (sq + 1 < nseq) load_tiles(row0 + TS, nv0);
            if (ob >= 0) {
                float* Cout = A.out + O_SC + (size_t)(ob * 4 + h) * 128 * 256 + sl * 64;
#pragma unroll
                for (int tn = 0; tn < 4; ++tn)
#pragma unroll
                    for (int r = 0; r < 4; ++r) Cout[(size_t)(16 * wid + 4 * fq + r) * 256 + 16 * tn + fr] = oC[tn][r];
                if (sl == 0) { if (tid < 128) A.out[O_SN + (size_t)(ob * 4 + h) * 128 + tid] = onv; if (tid == 0) A.out[O_SM + ob * 4 + h] = omm; }
                ob = -1;
            }
            RW_BAR();
#pragma unroll
            for (int tt = 0; tt < 2; ++tt) { const int tn = tn0 + tt; f32x4 d = (f32x4){0.f, 0.f, 0.f, 0.f};
#pragma unroll
                for (int ks = 0; ks < 4; ++ks) d = __builtin_amdgcn_mfma_f32_16x16x32_bf16(*(const LAS bf16x8*)(Qs + (16 * tm + fr) * 136 + 32 * ks + 8 * fq), *(const LAS bf16x8*)(Ks + (16 * tn + fr) * 136 + 32 * ks + 8 * fq), d, 0, 0, 0);
                const int s = 16 * tn + fr; const float as = AS[s];
#pragma unroll
                for (int r = 0; r < 4; ++r) { const int t = 16 * tm + 4 * fq + r; const float e = __expf(fminf(as - MX[t], 0.f)); const float val = s <= t ? d[r] * e : 0.f; Ss[t * 72 + s] = bf1(val); } }
            RW_BAR();
            {
                const int dt = tid >> 3, dp = tid & 7;
                const v4u xs = *(const LAS v4u*)(Ss + dt * 72 + 8 * dp);
                float s1 = (bflo(xs.x) + bfhi(xs.x)) + (bflo(xs.y) + bfhi(xs.y)) + (bflo(xs.z) + bfhi(xs.z)) + (bflo(xs.w) + bfhi(xs.w));
                const v4u q0 = *(const LAS v4u*)(Qs + dt * 136 + 16 * dp), q1 = *(const LAS v4u*)(Qs + dt * 136 + 16 * dp + 8); const LAS float* nv = NV + 16 * dp;
                const f32x4 n0 = *(const LAS f32x4*)nv, n1 = *(const LAS f32x4*)(nv + 4), n2 = *(const LAS f32x4*)(nv + 8), n3 = *(const LAS f32x4*)(nv + 12);
                float s2 = (bflo(q0.x) * n0.x + bfhi(q0.x) * n0.y) + (bflo(q0.y) * n0.z + bfhi(q0.y) * n0.w) + (bflo(q0.z) * n1.x + bfhi(q0.z) * n1.y) + (bflo(q0.w) * n1.z + bfhi(q0.w) * n1.w)
                         + (bflo(q1.x) * n2.x + bfhi(q1.x) * n2.y) + (bflo(q1.y) * n2.z + bfhi(q1.y) * n2.w) + (bflo(q1.z) * n3.x + bfhi(q1.z) * n3.y) + (bflo(q1.w) * n3.z + bfhi(q1.w) * n3.w);
                s1 = red8(s1); s2 = red8(s2);
                if (dp == 0) { DEN1[dt] = s1; DEN2[dt] = s2; }
            }
            f32x4 nsv[2], nqc[2];
#pragma unroll
            for (int tt = 0; tt < 2; ++tt) { const int tn = tn0 + tt; f32x4 d = (f32x4){0.f, 0.f, 0.f, 0.f}, e = (f32x4){0.f, 0.f, 0.f, 0.f};
#pragma unroll
                for (int ks = 0; ks < 2; ++ks) d = __builtin_amdgcn_mfma_f32_16x16x32_bf16(*(const LAS bf16x8*)(Ss + (16 * tm + fr) * 72 + 32 * ks + 8 * fq), *(const LAS bf16x8*)(VT + (16 * tn + fr) * 72 + 8 * ((4 * ks + fq) ^ (((16 * tn + fr) >> 3) & 7))), d, 0, 0, 0);
#pragma unroll
                for (int ks = 0; ks < 4; ++ks) e = __builtin_amdgcn_mfma_f32_16x16x32_bf16(*(const LAS bf16x8*)(Qs + (16 * tm + fr) * 136 + 32 * ks + 8 * fq), *(const LAS bf16x8*)(CT + (16 * tn + fr) * 136 + 32 * ks + 8 * fq), e, 0, 0, 0);
                nsv[tt] = d; nqc[tt] = e; }
            RW_BAR();
#pragma unroll
            for (int r = 0; r < 4; ++r) { const int t = 16 * tm + 4 * fq + r; const float wi = WINT[t]; const float den = DEN1[t] + wi * DEN2[t]; const float inv = 1.f / fmaxf(fabsf(den), EMR[t]);
                if (t < nvalid) {
#pragma unroll
                    for (int tt = 0; tt < 2; ++tt) { const float hv = (nsv[tt][r] + wi * nqc[tt][r]) * inv;
                        QKV[(size_t)(row0 + t0 + t) * 2048 + 1024 + h * 256 + sl * 64 + 16 * (tn0 + tt) + fr] = bf1(hv); } } }
            {
                const float decay = WINT[63];
#pragma unroll
                for (int tn = 0; tn < 4; ++tn) { f32x4 d = accC[tn] * decay;
#pragma unroll
                    for (int ks = 0; ks < 2; ++ks) d = __builtin_amdgcn_mfma_f32_16x16x32_bf16(*(const LAS bf16x8*)(KT + (16 * wid + fr) * 72 + 8 * ((4 * ks + fq) ^ (((16 * wid + fr) >> 3) & 7))), *(const LAS bf16x8*)(VT + (16 * tn + fr) * 72 + 8 * ((4 * ks + fq) ^ (((16 * tn + fr) >> 3) & 7))), d, 0, 0, 0);
                    accC[tn] = d;
                    v2u w; w.x = pk2(d[0], d[1]); w.y = pk2(d[2], d[3]); *(LAS v2u*)(CT + (16 * tn + fr) * 136 + 16 * wid + 4 * fq) = w; }
                {   const int nk = tid >> 2, np = tid & 3;
                    const v4u x = *(const LAS v4u*)(KT + nk * 72 + 16 * np), y = *(const LAS v4u*)(KT + nk * 72 + 16 * np + 8);
                    float s = ((bflo(x.x) + bfhi(x.x)) + (bflo(x.y) + bfhi(x.y))) + ((bflo(x.z) + bfhi(x.z)) + (bflo(x.w) + bfhi(x.w))) + ((bflo(y.x) + bfhi(y.x)) + (bflo(y.y) + bfhi(y.y))) + ((bflo(y.z) + bfhi(y.z)) + (bflo(y.w) + bfhi(y.w)));
                    s += dppf<0xB1>(s); s += dppf<0x4E>(s);
                    if (np == 0) NV[nk] = decay * NV[nk] + s; }
            }
        }
        __syncthreads();
        if (!prompt && sq + 1 < nseq) {
#pragma unroll
            for (int tn = 0; tn < 4; ++tn) oC[tn] = accC[tn];
            onv = tid < 128 ? NV[tid] : 0.f; omm = m_state; ob = b;
        } else {
            float* Cout = A.out + (prompt ? O_PC : O_SC) + (size_t)(b * 4 + h) * 128 * 256 + sl * 64;
#pragma unroll
            for (int tn = 0; tn < 4; ++tn)
#pragma unroll
                for (int r = 0; r < 4; ++r) Cout[(size_t)(16 * wid + 4 * fq + r) * 256 + 16 * tn + fr] = accC[tn][r];
            if (sl == 0) {
                if (tid < 128) A.out[(prompt ? O_PN : O_SN) + (size_t)(b * 4 + h) * 128 + tid] = NV[tid];
                if (tid == 0) A.out[(prompt ? O_PM : O_SM) + b * 4 + h] = m_state;
            }
        }
    }
    __syncthreads();
}

__device__ __forceinline__ void merge_rows(const Args& A, int gw, int NGW, int lane) {
    const unsigned char* G1 = (const unsigned char*)A.out; const bf16* QKV = (const bf16*)(A.ws + WS_QKV); bf16* HB = (bf16*)(A.ws + WS_PB); const float* ng = A.in[I_MNG];
    const int c0 = 16 * lane;
    float ngv[16];
#pragma unroll
    for (int i = 0; i < 4; ++i) { const f32x4 t = *(const f32x4*)(ng + c0 + 4 * i); ngv[4 * i] = t.x; ngv[4 * i + 1] = t.y; ngv[4 * i + 2] = t.z; ngv[4 * i + 3] = t.w; }
    v4u nha[2], nhb[2], nga, ngb, noa;
#define MERGE_LD(mm) do { const v4u* hap_ = (const v4u*)(QKV + (size_t)(mm) * 2048 + 1024 + c0); const v4u* hbp_ = (const v4u*)(HB + (size_t)(mm) * PBW + c0); nha[0] = hap_[0]; nha[1] = hap_[1]; nhb[0] = hbp_[0]; nhb[1] = hbp_[1]; \
        nga = *(const v4u*)(G1 + (size_t)(mm) * 3072 + c0); ngb = *(const v4u*)(G1 + (size_t)(mm) * 3072 + 1024 + c0); noa = *(const v4u*)(G1 + (size_t)(mm) * 3072 + 2048 + c0); } while (0)
    if (gw < NTOK) MERGE_LD(gw);
    for (int m = gw; m < NTOK; m += NGW) {
        const v4u hap[2] = {nha[0], nha[1]}, hbp[2] = {nhb[0], nhb[1]}; const v4u ga = nga, gb = ngb, oa = noa;
        if (m + NGW < NTOK) MERGE_LD(m + NGW);
        float ha[16], o[16];
#pragma unroll
        for (int i = 0; i < 2; ++i) { const v4u x = hap[i]; ha[8 * i + 0] = bflo(x.x); ha[8 * i + 1] = bfhi(x.x); ha[8 * i + 2] = bflo(x.y); ha[8 * i + 3] = bfhi(x.y); ha[8 * i + 4] = bflo(x.z); ha[8 * i + 5] = bfhi(x.z); ha[8 * i + 6] = bflo(x.w); ha[8 * i + 7] = bfhi(x.w); }
        float s = 0.f;
#pragma unroll
        for (int i = 0; i < 16; ++i) s += ha[i];
        const float mean = red16(s) * (1.f / 256.f); float q = 0.f;
#pragma unroll
        for (int i = 0; i < 16; ++i) { ha[i] -= mean; q += ha[i] * ha[i]; }
        const float rstd = __builtin_amdgcn_rsqf(red16(q) * (1.f / 256.f) + LN_EPS);
        const unsigned gav[4] = {ga.x, ga.y, ga.z, ga.w}, gbv[4] = {gb.x, gb.y, gb.z, gb.w}, oav[4] = {oa.x, oa.y, oa.z, oa.w};
#pragma unroll
        for (int i = 0; i < 2; ++i) { const v4u hb = hbp[i]; const unsigned hbv[4] = {hb.x, hb.y, hb.z, hb.w};
#pragma unroll
            for (int j = 0; j < 4; ++j) { const int e = 8 * i + 2 * j; const int wq = e >> 2, sh = (e & 3) * 8;
                const float n0 = ngv[e], n1 = ngv[e + 1]; const float k255 = 1.f / 255.f;
                const float sa0 = (float)((gav[wq] >> sh) & 0xffu) * k255, sa1 = (float)((gav[wq] >> (sh + 8)) & 0xffu) * k255;
                const float sb0 = (float)((gbv[wq] >> sh) & 0xffu) * k255, sb1 = (float)((gbv[wq] >> (sh + 8)) & 0xffu) * k255;
                const float so0 = (float)((oav[wq] >> sh) & 0xffu) * k255, so1 = (float)((oav[wq] >> (sh + 8)) & 0xffu) * k255;
                o[e] = sa0 * (ha[e] * rstd * n0 * so0) + sb0 * bflo(hbv[j]);
                o[e + 1] = sa1 * (ha[e + 1] * rstd * n1 * so1) + sb1 * bfhi(hbv[j]); } }
        v4u* op = (v4u*)(HB + (size_t)m * PBW + c0);
#pragma unroll
        for (int i = 0; i < 2; ++i) { v4u w; w.x = pk2(o[8 * i], o[8 * i + 1]); w.y = pk2(o[8 * i + 2], o[8 * i + 3]); w.z = pk2(o[8 * i + 4], o[8 * i + 5]); w.w = pk2(o[8 * i + 6], o[8 * i + 7]); op[i] = w; }
    }
}
template <bool TO_BF16> __device__ __forceinline__ void ln_rows(const float* src, void* dst, const float* g, const float* bta, int nrows, int gw, int NGW, int lane, const float* part = nullptr, const LAS signed char* tmap = nullptr) {
    f32x4 nx[4];
    if (gw < nrows) { const f32x4* xr = (const f32x4*)(src + (size_t)gw * DM) + lane;
#pragma unroll
        for (int j = 0; j < 4; ++j) nx[j] = xr[64 * j]; }
    for (int m = gw; m < nrows; m += NGW) {
        f32x4 v[4]; float s = 0.f;
#pragma unroll
        for (int j = 0; j < 4; ++j) v[j] = nx[j];
        if (part) {
            const int r = m < 16384 ? (m >> 11) * TP + (m & 2047) + NMETA : m + 128; const int pm = r >> 8, rit = r & 255;
#pragma unroll
            for (int j = 0; j < 4; ++j) { const int ix = tmap[pm * 4 + j]; if (ix >= 0) v[j] = (v[j] + *(const f32x4*)(part + (size_t)(2 * ix) * 65536 + (size_t)rit * 256 + 4 * lane)) + *(const f32x4*)(part + (size_t)(2 * ix + 1) * 65536 + (size_t)rit * 256 + 4 * lane); }
        }
#pragma unroll
        for (int j = 0; j < 4; ++j) s += (v[j].x + v[j].y) + (v[j].z + v[j].w);
        if (m + NGW < nrows) { const f32x4* xr = (const f32x4*)(src + (size_t)(m + NGW) * DM) + lane;
#pragma unroll
            for (int j = 0; j < 4; ++j) nx[j] = xr[64 * j]; }
        const float mean = wave_sum(s) * (1.f / DM); float s2 = 0.f;
#pragma unroll
        for (int j = 0; j < 4; ++j) { v[j] = v[j] - mean; s2 += (v[j].x * v[j].x + v[j].y * v[j].y) + (v[j].z * v[j].z + v[j].w * v[j].w); }
        const float rstd = __builtin_amdgcn_rsqf(wave_sum(s2) * (1.f / DM) + LN_EPS);
#pragma unroll
        for (int j = 0; j < 4; ++j) { const f32x4 gg = ((const f32x4*)g)[lane + 64 * j], bb = ((const f32x4*)bta)[lane + 64 * j]; v[j] = v[j] * rstd * gg + bb; }
        if (TO_BF16) { unsigned long long* o8 = (unsigned long long*)((bf16*)dst + (size_t)m * DM) + lane;
#pragma unroll
            for (int j = 0; j < 4; ++j) o8[64 * j] = (unsigned long long)pk2(v[j].x, v[j].y) | ((unsigned long long)pk2(v[j].z, v[j].w) << 32); }
        else { f32x4* o = (f32x4*)((float*)dst + (size_t)m * DM) + lane;
#pragma unroll
            for (int j = 0; j < 4; ++j) o[64 * j] = v[j]; }
    }
}
__device__ __forceinline__ float gelu_tanh(float x) { const float u = 0.7978845608028654f * (x + 0.044715f * x * x * x); return 0.5f * x * (1.f + tanhf_(u)); }
__device__ __forceinline__ void unpack8(const v4u x, float (&f)[8]) { f[0] = bflo(x.x); f[1] = bfhi(x.x); f[2] = bflo(x.y); f[3] = bfhi(x.y); f[4] = bflo(x.z); f[5] = bfhi(x.z); f[6] = bflo(x.w); f[7] = bfhi(x.w); }
__device__ __forceinline__ void conv_pass(const Args& A, int gtid, int nthr) {
    bf16* UP = (bf16*)(A.ws + WS_UP); const float* cw = A.in[I_CW]; const float* cb = A.in[I_CB];
    constexpr int NG = DFF / 8;
    const int nitems = (NTOK / 8) * NG;
    for (int it = gtid; it < nitems; it += nthr) {
        const int rb = it / NG, fg = it - rb * NG; const int ff = 8 * fg; const int row0 = 8 * rb;
        const int pc = 256 * (ff >> 7) + (ff & 127);
        bool prompt = row0 < NP; int seq, t0, T;
        if (prompt) { seq = row0 / TP; t0 = row0 - seq * TP; T = TP; } else { seq = (row0 - NP) >> 3; t0 = 0; T = TS; }
        float w0[8], w1[8], w2[8], bb[8], g1[8], g2[8];
        { const f32x4* p = (const f32x4*)(cw + ff); const f32x4 a = p[0], b = p[1]; w0[0] = a.x; w0[1] = a.y; w0[2] = a.z; w0[3] = a.w; w0[4] = b.x; w0[5] = b.y; w0[6] = b.z; w0[7] = b.w; }
        { const f32x4* p = (const f32x4*)(cw + DFF + ff); const f32x4 a = p[0], b = p[1]; w1[0] = a.x; w1[1] = a.y; w1[2] = a.z; w1[3] = a.w; w1[4] = b.x; w1[5] = b.y; w1[6] = b.z; w1[7] = b.w; }
        { const f32x4* p = (const f32x4*)(cw + 2 * DFF + ff); const f32x4 a = p[0], b = p[1]; w2[0] = a.x; w2[1] = a.y; w2[2] = a.z; w2[3] = a.w; w2[4] = b.x; w2[5] = b.y; w2[6] = b.z; w2[7] = b.w; }
        { const f32x4* p = (const f32x4*)(cb + ff); const f32x4 a = p[0], b = p[1]; bb[0] = a.x; bb[1] = a.y; bb[2] = a.z; bb[3] = a.w; bb[4] = b.x; bb[5] = b.y; bb[6] = b.z; bb[7] = b.w; }
        if (t0 > 0) { unpack8(*(const v4u*)(UP + (size_t)(row0 - 2) * 5632 + pc), g2); unpack8(*(const v4u*)(UP + (size_t)(row0 - 1) * 5632 + pc), g1); }
        else if (!prompt) { const float* c0 = A.in[I_FCV] + (size_t)seq * 2 * DFF + ff;
#pragma unroll
            for (int j = 0; j < 8; ++j) { g2[j] = c0[j]; g1[j] = c0[DFF + j]; } }
        else {
#pragma unroll
            for (int j = 0; j < 8; ++j) { g2[j] = 0.f; g1[j] = 0.f; } }
#pragma unroll
        for (int r = 0; r < 8; ++r) {
            bf16* rp = UP + (size_t)(row0 + r) * 5632 + pc; float g0[8], vv[8], o[8];
            unpack8(*(const v4u*)rp, g0); unpack8(*(const v4u*)(rp + 128), vv);
#pragma unroll
            for (int j = 0; j < 8; ++j) { const float cv = bb[j] + w0[j] * g2[j] + w1[j] * g1[j] + w2[j] * g0[j]; o[j] = gelu_tanh(cv) * vv[j]; g2[j] = g1[j]; g1[j] = g0[j]; }
            v4u w; w.x = pk2(o[0], o[1]); w.y = pk2(o[2], o[3]); w.z = pk2(o[4], o[5]); w.w = pk2(o[6], o[7]); *(v4u*)(rp + 128) = w;
        }
        if (t0 + 8 == T) {
            float* co = A.out + (prompt ? O_PCV : O_SCV) + (size_t)seq * 2 * DFF + ff;
#pragma unroll
            for (int j = 0; j < 8; ++j) { co[j] = g2[j]; co[DFF + j] = g1[j]; } }
    }
}

#define RLX_AGENT __ATOMIC_RELAXED, __HIP_MEMORY_SCOPE_AGENT
#define XB_TMO      128
#define XB_XCNT(j)  (256  + 64 * (j))
#define XB_XSUB(j)  (1280 + 64 * (j))
#define XB_XGEN(j)  (2304 + 64 * (j))
#define XB_TOP      3328
#define XB_TOPGEN   3392
#define XCD_BAR_WORDS 3456
#define XB_SPIN_CAP (1u << 18)

__device__ __forceinline__ unsigned xb_ld(unsigned* p)              { return __hip_atomic_load(p, __ATOMIC_RELAXED, __HIP_MEMORY_SCOPE_AGENT); }
__device__ __forceinline__ unsigned xb_add(unsigned* p, unsigned v) { return __hip_atomic_fetch_add(p, v, __ATOMIC_RELAXED, __HIP_MEMORY_SCOPE_AGENT); }
__device__ __forceinline__ unsigned xb_xcc_id() { return (unsigned)__builtin_amdgcn_s_getreg((3 << 11) | 20) & 0xFu; }
#define XB_SPIN(cond, bar) do { unsigned _sp = 0; while (cond) { __builtin_amdgcn_s_sleep(1); \
    if ((++_sp & 255u) == 0u) { if (xb_ld(&(bar)[XB_TMO])) break; if (_sp > XB_SPIN_CAP) { atomicAdd(&(bar)[XB_TMO], 1u); break; } } } } while (0)

struct XcdBarrier {
    unsigned* bar; unsigned x;
    volatile LAS unsigned* st;
};

__device__ __forceinline__ XcdBarrier xcd_barrier_post(unsigned* bar, volatile LAS unsigned* st) {
    XcdBarrier b; b.bar = bar; b.x = xb_xcc_id(); b.st = st;
    if (threadIdx.x == 0) (void)xb_add(&bar[XB_XCNT(b.x)], 1u);
    return b;
}
__device__ __forceinline__ void xcd_barrier_complete(unsigned* bar, unsigned x, unsigned& nloc, unsigned& nx) {
    const unsigned G = gridDim.x * gridDim.y * gridDim.z;
    unsigned sum, cnt, mine, sp = 0u;
    for (;;) {
        sum = 0u; cnt = 0u; mine = 0u;
#pragma unroll
        for (unsigned j = 0; j < 16; ++j) { const unsigned c = xb_ld(&bar[XB_XCNT(j)]); sum += c; cnt += (c > 0u) ? 1u : 0u; mine = (j == x) ? c : mine; }
        if (sum == G) break;
        __builtin_amdgcn_s_sleep(1);
        if ((++sp & 255u) == 0u) { if (xb_ld(&bar[XB_TMO])) break; if (sp > XB_SPIN_CAP) { atomicAdd(&bar[XB_TMO], 1u); break; } }
    }
    nloc = mine > 0u ? mine : 1u; nx = cnt > 0u ? cnt : 1u;
}

__device__ __forceinline__ void xcd_barrier(const XcdBarrier& b) {
    asm volatile("s_waitcnt vmcnt(0)" ::: "memory");
    __syncthreads();
    if (threadIdx.x == 0) {
        unsigned* bar = b.bar;
        __builtin_amdgcn_s_waitcnt(0);
        unsigned nloc = b.st[0], nx = b.st[1];
        if (nloc == 0u) { xcd_barrier_complete(bar, b.x, nloc, nx); b.st[0] = nloc; b.st[1] = nx; }
        const unsigned old = xb_add(&bar[XB_XSUB(b.x)], 1u);
        const unsigned gen = old / nloc;
        if (old + 1u == (gen + 1u) * nloc) {
            __builtin_amdgcn_fence(__ATOMIC_RELEASE, "agent");
            asm volatile("s_waitcnt vmcnt(0)" ::: "memory");
            const unsigned og = xb_add(&bar[XB_TOP], 1u);
            const unsigned tg = og / nx;
            if (og + 1u == (tg + 1u) * nx) xb_add(&bar[XB_TOPGEN], 1u);
            else XB_SPIN(xb_ld(&bar[XB_TOPGEN]) == tg, bar);
            __builtin_amdgcn_fence(__ATOMIC_ACQUIRE, "agent");
            xb_add(&bar[XB_XGEN(b.x)], 1u);
            asm volatile("s_waitcnt vmcnt(0)" ::: "memory");
        } else {
            XB_SPIN(xb_ld(&bar[XB_XGEN(b.x)]) == gen, bar);
            __builtin_amdgcn_fence(__ATOMIC_ACQUIRE, "agent");
            asm volatile("s_waitcnt vmcnt(0)" ::: "memory");
        }
    }
    __syncthreads();
}

__global__ void __launch_bounds__(512, 2) fwd_megakernel(Args A) {
    extern __shared__ __attribute__((aligned(16))) unsigned char lds_raw[];
    cg::grid_group grid = cg::this_grid();
    LAS unsigned char* lds = (LAS unsigned char*)lds_raw;
    const int G = gridDim.x, bid = blockIdx.x, NGW = G * 8;
    if (threadIdx.x < 32) ((LAS unsigned*)(lds + LDS_CTL))[threadIdx.x] = 0u;
    __syncthreads();
    XcdBarrier bar = xcd_barrier_post((unsigned*)(A.ws + WS_CTL) + 4096, (volatile LAS unsigned*)(lds + LDS_CTL + 64));
#define FRESH() int tid = threadIdx.x; asm volatile("" : "+v"(tid)); const int lane = tid & 63, wid = __builtin_amdgcn_readfirstlane(tid >> 6), gw = bid * 8 + wid; (void)lane; (void)gw
    unsigned char* ws = A.ws;
    bf16* XN = (bf16*)(ws + WS_XN); bf16* WinT = (bf16*)(ws + WS_WIN); bf16* WoT = (bf16*)(ws + WS_WO); bf16* WupT = (bf16*)(ws + WS_WUP); bf16* WdT = (bf16*)(ws + WS_WD);
    bf16* PB = (bf16*)(ws + WS_PB); bf16* QKV = (bf16*)(ws + WS_QKV); bf16* G1 = (bf16*)(ws + WS_G1); float* PRE1 = (float*)(ws + WS_PRE1); bf16* UP = (bf16*)(ws + WS_UP);

    { FRESH(); p0_prologue(A, lds, gw, NGW, wid, lane, tid, G >= 256); }
    grid.sync();
    { pg8::Gemm g{XN, WinT, MROWS, 5376, 1024, 1024, 256}; pg8::StaticOrder S; S.init(MROWS, 5376, G, bid);
      pg8::EpiProj E{PB, PBW, 13, QKV, 2048};
      pg8::gemm_phase<pg8::EpiProj, pg8::StaticOrder, true, true>(lds, g, S, E); }
    xcd_barrier(bar);
    { FRESH(); lora_act_pass(A, bid * 512 + tid, G * 512); }
    xcd_barrier(bar);
    {
        const int nrw = (G >= 256) ? 128 : 0;
        if (bid < nrw) {
            int tid = threadIdx.x; asm volatile("" : "+v"(tid)); const int lane = tid & 63, wid = __builtin_amdgcn_readfirstlane(tid >> 6);
            rwkv_item<true>(A, lds, bid >> 4, 1, bid & 15, tid, wid, lane);
            pg8::Gemm g{XN, WinT + (size_t)5376 * 1024, MROWS, 3072, 1024, 1024, 256}; pg8::StaticOrder S; S.init(MROWS, 3072, nrw, bid); S.off = G1_SPLIT;
            pg8::EpiSigU8 E{(unsigned char*)A.out, 3072};
            pg8::gemm_phase<pg8::EpiSigU8, pg8::StaticOrder, true, true>(lds, g, S, E);
        } else {
            unsigned* ctr = (unsigned*)(ws + WS_CTL);
            LAS unsigned* qslot = (LAS unsigned*)(lds + LDS_CTL);
            for (;;) {
                int tid = threadIdx.x; asm volatile("" : "+v"(tid)); const int lane = tid & 63, wid = __builtin_amdgcn_readfirstlane(tid >> 6);
                if (tid == 0) qslot[0] = (unsigned)nrw + atomicAdd(ctr, 1u);
                __syncthreads();
                const int q = (int)qslot[0];
                __syncthreads();
                if (q >= 512 + 256) break;
                if (q < 128) rwkv_item<true>(A, lds, q >> 4, 1, q & 15, tid, wid, lane);
                else if (q < 256) { const int i = q - 128; mlstm_item(A, lds, true, i >> 4, 1, (i >> 2) & 3, i & 3, tid, wid, lane); }
                else if (q < 512) { const int i = q - 256; rwkv_item<false>(A, lds, (i >> 4) * 8, 8, i & 15, tid, wid, lane); }
                else { const int i = q - 512; mlstm_item(A, lds, false, (i >> 4) * 8, 8, (i >> 2) & 3, i & 3, tid, wid, lane); }
            }
            pg8::Gemm g{XN, WinT + (size_t)5376 * 1024, MROWS, 3072, 1024, 1024, 256}; pg8::StaticOrder S; S.init(MROWS, 3072, G - nrw, bid - nrw); S.end = nrw ? G1_SPLIT : 0;
            pg8::EpiSigU8 E{(unsigned char*)A.out, 3072};
            pg8::gemm_phase<pg8::EpiSigU8, pg8::StaticOrder, true, true>(lds, g, S, E);
            if (nrw) { int tq = threadIdx.x; asm volatile("" : "+v"(tq)); const int wq = __builtin_amdgcn_readfirstlane(tq >> 6); __syncthreads(); weight_items(A, lds, 1, (bid - nrw) * 8 + wq, (G - nrw) * 8, wq, tq & 63); }
        }
    }
    xcd_barrier(bar);
    { FRESH(); merge_rows(A, gw, NGW, lane); }
    xcd_barrier(bar);
    { pg8::Gemm g{PB, WoT, MROWS, 1024, 1024, PBW, 256}; pg8::StaticOrder S; S.init(MROWS, 1024, G, bid);
      pg8::EpiRes<false> E{XN, PRE1, ALPHA, nullptr};
      pg8::gemm_phase<pg8::EpiRes<false>, pg8::StaticOrder, true, true>(lds, g, S, E); }
    xcd_barrier(bar);
    { FRESH(); ln_rows<true>(PRE1, XN, A.in[I_L1G], A.in[I_L1B], NTOK, gw, NGW, lane); }
    xcd_barrier(bar);
    { pg8::Gemm g{XN, WupT, MROWS, 5632, 1024, 1024, 256}; pg8::StaticOrder S; S.init(MROWS, 5632, G, bid);
      pg8::EpiProj E{UP, 5632, 1 << 20, UP, 5632};
      pg8::gemm_phase<pg8::EpiProj, pg8::StaticOrder, true, true>(lds, g, S, E); }
    xcd_barrier(bar);
    { FRESH(); conv_pass(A, bid * 512 + tid, G * 512); }
    xcd_barrier(bar);
    { pg8::Gemm g{UP + 128, WdT, MROWS, 1024, DFF, 5632, 512};
      pg8::EpiRes<true> E{XN, A.out, ALPHA, (float*)(ws + WS_PART)};
      if (G == 256) { pg8::TailSplitOrder S; S.init(MROWS, 1024, DFF, G, bid); pg8::gemm_phase<pg8::EpiRes<true>, pg8::TailSplitOrder, true, true>(lds, g, S, E); }
      else { pg8::StaticOrder S; S.init(MROWS, 1024, G, bid); pg8::gemm_phase<pg8::EpiRes<true>, pg8::StaticOrder, true, true>(lds, g, S, E); } }
    xcd_barrier(bar);
    { FRESH();
      LAS signed char* tmap = (LAS signed char*)lds;
      const bool tail = (G == 256);
      if (tid < 276) tmap[tid] = -1;
      __syncthreads();
      if (tail && tid < 20) { pg8::StaticOrder b1; b1.init(MROWS, 1024, 1, 0); pg8::Unit u; b1.next(256 + tid, u); tmap[u.pm * 4 + u.pn] = (signed char)tid; }
      __syncthreads();
      ln_rows<false>(A.out, A.out, A.in[I_L2G], A.in[I_L2B], 8 * 2048 + NS, gw, NGW, lane, tail ? (const float*)(ws + WS_PART) : nullptr, tmap); }
}

extern "C" void kernel_launch(void* const* d_in, const int* in_sizes, int n_in, void* d_out, int out_size, void* d_ws, size_t ws_size, hipStream_t stream) {
    static int grid = 0;
    if (grid == 0) {
        if (n_in != 34 || (size_t)out_size != O_END || ws_size < WS_END) { fprintf(stderr, "kernel_launch: unexpected shapes: n_in %d out %d ws %zu\n", n_in, out_size, ws_size); grid = -1; return; }
        int dev = 0, cus = 0, per_cu = 0;
        hipGetDevice(&dev); hipDeviceGetAttribute(&cus, hipDeviceAttributeMultiprocessorCount, dev);
        hipFuncSetAttribute((const void*)fwd_megakernel, hipFuncAttributeMaxDynamicSharedMemorySize, LDS_BYTES);
        hipOccupancyMaxActiveBlocksPerMultiprocessor(&per_cu, (const void*)fwd_megakernel, 512, LDS_BYTES);
        if (per_cu < 1) { fprintf(stderr, "kernel_launch: occupancy query says %d blocks per CU\n", per_cu); per_cu = 1; }
        grid = cus;
        (void)hipGetLastError();
    }
    if (grid < 0) return;
    hipMemsetAsync((char*)d_ws + WS_CTL, 0, 65536, stream);
    Args a{};
    for (int i = 0; i < 34; ++i) a.in[i] = (const float*)d_in[i];
    a.out = (float*)d_out; a.ws = (unsigned char*)d_ws;
    void* args[] = {&a};
    hipError_t e = hipLaunchCooperativeKernel((const void*)fwd_megakernel, dim3(grid), dim3(512), args, LDS_BYTES, stream);
    if (e != hipSuccess) fprintf(stderr, "cooperative launch failed: %s (grid %d)\n", hipGetErrorString(e), grid);
}
```

```cpp
#include <hip/hip_runtime.h>
#include <hip/hip_cooperative_groups.h>
#include <cstdio>
#include <cstdint>
namespace cg = cooperative_groups;
namespace pg8 {
#define PG8_LAS __attribute__((address_space(3)))
typedef unsigned short bf16_t;
typedef short bf16x8 __attribute__((ext_vector_type(8)));
typedef float f32x4 __attribute__((ext_vector_type(4)));
typedef unsigned u32x4 __attribute__((ext_vector_type(4)));
constexpr int BM = 256, BK = 64, HALF = 128, HTB = HALF * BK * 2  , STAGE_BYTES = 8 * HTB, NXCD = 8, WGM = 8;

__host__ __device__ __forceinline__ int lds_byte(int r, int c) { const int st = (r >> 4) * 2 + (c >> 5), rr = r & 15, cc = c & 31, ob = rr * 64 + cc * 2; return st * 1024 + (ob ^ (((ob >> 9) & 1) << 5)); }
__host__ __device__ __forceinline__ void stage_rc(int b, int& R, int& C) { const int st = b / 1024, sb = b % 1024, swz = sb ^ (((sb >> 9) & 1) << 5); R = (st >> 1) * 16 + swz / 64; C = (st & 1) * 32 + (swz % 64) / 2; }
__host__ __device__ __forceinline__ int perm32(int rho) { const int n = rho >> 4, i = rho & 15; return 8 * (i >> 2) + 4 * n + (i & 3); }

struct Unit { int pm, pn, nt = 0, kofs = 0, aux = 0; };
struct Gemm { const bf16_t* A; const bf16_t* Bt; int M, N, K, lda, kpA; };

struct StaticOrder {
    int nM, nN, nwg, G, c, off = 0, end = 0;
    __host__ __device__ void init(int M, int N, int G_, int c_) { nM = M / BM; nN = N / BM; nwg = nM * nN; G = G_; c = c_; }
    __host__ __device__ bool next(int i, Unit& u) const {
        const long L = (long)i * G + c + off; if (L >= (end ? end : nwg)) return false;
        int wgid = (int)L; { const int q = nwg / NXCD, r = nwg % NXCD, xcd = wgid % NXCD, off = wgid / NXCD; wgid = (xcd < r ? xcd * (q + 1) : r * (q + 1) + (xcd - r) * q) + off; }
        const int nig = WGM * nN, gid = wgid / nig, fm = gid * WGM, gsz = (nM - fm) < WGM ? (nM - fm) : WGM;
        u.pm = fm + ((wgid % nig) % gsz); u.pn = (wgid % nig) / gsz; return true;
    }
    __device__ __forceinline__ void a_ready(const Unit&) const {}
    __device__ __forceinline__ void done(const Unit&) const {}
};


struct TailSplitOrder {
    StaticOrder base; int ntk;
    __host__ __device__ void init(int M, int N, int K, int G_, int c_) { base.init(M, N, G_, c_); ntk = K / BK; }
    __host__ __device__ bool next(int i, Unit& u) const {
        const int G = base.G, T = base.nwg; StaticOrder b1 = base; b1.G = 1; b1.c = 0;
        if (i == 0) { if (base.c >= T) return false; b1.next(base.c, u); u.nt = 0; u.kofs = 0; return true; }
        if (i == 1) { const int l = base.c; if (l >= 3 * (T - G)) return false; const int tl = l / 3, pc = l - 3 * tl; b1.next(G + tl, u);
            const int n0 = ((ntk / 3 + 2) >> 1) << 1, n1 = (((ntk - n0) / 2 + 1) >> 1) << 1;
            u.nt = pc == 0 ? n0 : (pc == 1 ? n1 : ntk - n0 - n1); u.kofs = pc == 0 ? 0 : (pc == 1 ? n0 : n0 + n1); u.aux = 2 * tl + (pc - 1); return true; }
        return false;
    }
    __device__ __forceinline__ void a_ready(const Unit&) const {}
    __device__ __forceinline__ void done(const Unit&) const {}
};

__device__ __forceinline__ unsigned cvt_pk_bf16(float lo, float hi) { unsigned r; asm volatile("v_cvt_pk_bf16_f32 %0, %1, %2" : "=v"(r) : "v"(lo), "v"(hi)); return r; }
struct EpiProj {
    static constexpr bool PERM = true, AFTER_DRAIN = false;
    bf16_t* O0; int ld0; int nt0; bf16_t* O1; int ld1;
    __device__ __forceinline__ void operator()(const f32x4 (&acc)[2][2][4][2], const Unit& u, int wr, int wc, int fr, int fq) const {
        const bool first = u.pn < nt0; bf16_t* base = first ? O0 : O1; const int ldc = first ? ld0 : ld1; const int colt = (first ? u.pn : u.pn - nt0) * BM;
        const int row0 = u.pm * BM + wr * 64 + fr, col0 = colt + wc * 32 + 8 * fq;
#pragma unroll
        for (int ai = 0; ai < 2; ++ai)
#pragma unroll
            for (int m = 0; m < 4; ++m) { bf16_t* rowp = base + (size_t)(row0 + ai * HALF + m * 16) * ldc + col0;
#pragma unroll
                for (int bj = 0; bj < 2; ++bj) { const f32x4 v0 = acc[ai][bj][m][0], v1 = acc[ai][bj][m][1];
                    u32x4 w; w.x = cvt_pk_bf16(v0[0], v0[1]); w.y = cvt_pk_bf16(v0[2], v0[3]); w.z = cvt_pk_bf16(v1[0], v1[1]); w.w = cvt_pk_bf16(v1[2], v1[3]);
                    *(u32x4*)(rowp + bj * HALF) = w; } }
    }
};

struct EpiSigU8 {
    static constexpr bool PERM = true, AFTER_DRAIN = false;
    unsigned char* O; int ldc;
    __device__ __forceinline__ unsigned q8(float x) const { return (unsigned)(__builtin_amdgcn_rcpf(1.f + __expf(-x)) * 255.f + 0.5f); }
    __device__ __forceinline__ void operator()(const f32x4 (&acc)[2][2][4][2], const Unit& u, int wr, int wc, int fr, int fq) const {
        const int row0 = u.pm * BM + wr * 64 + fr, col0 = u.pn * BM + wc * 32 + 8 * fq;
#pragma unroll
        for (int ai = 0; ai < 2; ++ai)
#pragma unroll
            for (int m = 0; m < 4; ++m) { unsigned char* rowp = O + (size_t)(row0 + ai * HALF + m * 16) * ldc + col0;
#pragma unroll
                for (int bj = 0; bj < 2; ++bj) { const f32x4 v0 = acc[ai][bj][m][0], v1 = acc[ai][bj][m][1];
                    unsigned long long w = (unsigned long long)(q8(v0[0]) | (q8(v0[1]) << 8) | (q8(v0[2]) << 16) | (q8(v0[3]) << 24)) |
                                           ((unsigned long long)(q8(v1[0]) | (q8(v1[1]) << 8) | (q8(v1[2]) << 16) | (q8(v1[3]) << 24)) << 32);
                    *(unsigned long long*)(rowp + bj * HALF) = w; } }
    }
};
__device__ __forceinline__ float bf_lo(unsigned x) { return __builtin_bit_cast(float, x << 16); }
__device__ __forceinline__ float bf_hi(unsigned x) { return __builtin_bit_cast(float, x & 0xffff0000u); }
template <bool YMAP> struct EpiRes {
    static constexpr bool PERM = true, AFTER_DRAIN = false;
    const bf16_t* X; float* O; float alpha_; float* part;
    __device__ __forceinline__ void operator()(const f32x4 (&acc)[2][2][4][2], const Unit& u, int wr, int wc, int fr, int fq) const {
        const int row0 = u.pm * BM + wr * 64 + fr, col0 = u.pn * BM + wc * 32 + 8 * fq;
        if (YMAP && u.nt != 0 && u.kofs != 0) {
            float* pb = part + (size_t)u.aux * 65536 + (size_t)(wr * 64 + fr) * 256 + wc * 32 + 8 * fq;
#pragma unroll
            for (int ai = 0; ai < 2; ++ai)
#pragma unroll
                for (int m = 0; m < 4; ++m)
#pragma unroll
                    for (int bj = 0; bj < 2; ++bj) { float* op = pb + (size_t)(ai * HALF + m * 16) * 256 + bj * HALF; *(f32x4*)op = acc[ai][bj][m][0]; *(f32x4*)(op + 4) = acc[ai][bj][m][1]; }
            return;
        }
#pragma unroll
        for (int ai = 0; ai < 2; ++ai)
#pragma unroll
            for (int m = 0; m < 4; ++m) { const int row = row0 + ai * HALF + m * 16; int orow = row;
                if (YMAP) { if (row < 16512) { const int b = row / 2064, t = row - b * 2064; orow = t < 16 ? -1 : b * 2048 + t - 16; } else if (row < 17536) orow = row - 128; else orow = -1; }
                if (orow >= 0) {
#pragma unroll
                for (int bj = 0; bj < 2; ++bj) { const u32x4 x = *(const u32x4*)(X + (size_t)row * 1024 + col0 + bj * HALF);
                    f32x4 o0 = acc[ai][bj][m][0], o1 = acc[ai][bj][m][1]; const float alpha = alpha_;
                    o0[0] += alpha * bf_lo(x.x); o0[1] += alpha * bf_hi(x.x); o0[2] += alpha * bf_lo(x.y); o0[3] += alpha * bf_hi(x.y);
                    o1[0] += alpha * bf_lo(x.z); o1[1] += alpha * bf_hi(x.z); o1[2] += alpha * bf_lo(x.w); o1[3] += alpha * bf_hi(x.w);
                    float* op = O + (size_t)orow * 1024 + col0 + bj * HALF;
                    *(f32x4*)op = o0; *(f32x4*)(op + 4) = o1; } } }
    }
};
template <class Epi, class Sched, bool ALIGN_EPI = false, bool SP2 = false>
__device__ __forceinline__ void gemm_phase(PG8_LAS unsigned char* lds, const Gemm g, const Sched& S, const Epi& E) {
    int tid_ = threadIdx.x; asm volatile("" : "+v"(tid_));
    const int tid = tid_, wid = __builtin_amdgcn_readfirstlane(tid >> 6), lane = tid & 63, wr = wid >> 2, wc = wid & 3, fr = lane & 15, fq = lane >> 4;
    const int K = g.K, nt_all = K / BK;
    unsigned voffA[2], voffB[2];
#pragma unroll
    for (int i = 0; i < 2; ++i) { int R, C; stage_rc(tid * 16 + i * 8192, R, C); const int Rb = Epi::PERM ? ((R & ~31) + perm32(R & 31)) : R;
        voffA[i] = (unsigned)(R * g.lda + C) * 2u; voffB[i] = (unsigned)(Rb * K + C) * 2u; }
    const size_t kstep = (size_t)(BK * 2);
    const size_t hstepA = (size_t)HALF * g.lda * 2, hstepB = (size_t)HALF * K * 2, kpA = (size_t)g.kpA;
    const size_t tstepA = 2 * hstepA, tstepB = 2 * hstepB;
    const unsigned ldsw = (unsigned)wid * 1024u;
    const int aoff = lds_byte(wr * 64 + fr, fq * 8), boff = lds_byte(wc * 32 + fr, fq * 8);
#define PG8_SA(b, h) (((b) * 2 + (h)) * HTB)
#define PG8_SB(b, h) ((4 + (b) * 2 + (h)) * HTB)
#define PG8_STAGE(bufoff, gbase, voff) do { _Pragma("unroll") for (int _i = 0; _i < 2; ++_i) \
        __builtin_amdgcn_global_load_lds((const unsigned*)((const char*)(gbase) + (voff)[_i]), (PG8_LAS unsigned*)(lds + (bufoff) + ldsw + _i * 8192), 16, 0, 0); } while (0)
#define PG8_LDA(dst, b, h) do { _Pragma("unroll") for (int m = 0; m < 4; ++m) _Pragma("unroll") for (int k = 0; k < 2; ++k) dst[m][k] = *(const PG8_LAS bf16x8*)(lds + PG8_SA(b, h) + aoff + m * 2048 + k * 1024); } while (0)
#define PG8_LDB(dst, b, h) do { _Pragma("unroll") for (int n = 0; n < 2; ++n) _Pragma("unroll") for (int k = 0; k < 2; ++k) dst[n][k] = *(const PG8_LAS bf16x8*)(lds + PG8_SB(b, h) + boff + n * 2048 + k * 1024); } while (0)
#define PG8_MMA(ai, bj, At, Bt) do { __builtin_amdgcn_s_setprio(1); _Pragma("unroll") for (int m = 0; m < 4; ++m) _Pragma("unroll") for (int n = 0; n < 2; ++n) _Pragma("unroll") for (int k = 0; k < 2; ++k) \
        acc[ai][bj][m][n] = __builtin_amdgcn_mfma_f32_16x16x32_bf16(Bt[n][k], At[m][k], acc[ai][bj][m][n], 0, 0, 0); __builtin_amdgcn_s_setprio(0); } while (0)
#define PG8_WAIT_V(n) asm volatile("s_waitcnt vmcnt(" #n ")" ::: "memory")
#define PG8_WAIT_L(n) asm volatile("s_waitcnt lgkmcnt(" #n ")" ::: "memory")
#define PG8_BAR __builtin_amdgcn_s_barrier()
#define PG8_SCHED __builtin_amdgcn_sched_barrier(0)
    Unit cur, nxt; int ui = 0;
    if (!S.next(0, cur)) return;
    f32x4 acc[2][2][4][2];
#pragma unroll
    for (int a = 0; a < 2; ++a)
#pragma unroll
        for (int b = 0; b < 2; ++b)
#pragma unroll
            for (int m = 0; m < 4; ++m)
#pragma unroll
                for (int n = 0; n < 2; ++n) acc[a][b][m][n] = (f32x4){0.f, 0.f, 0.f, 0.f};
    bf16x8 At[4][2], B0[2][2], B1[2][2];
    const char* cA = (const char*)g.A + (size_t)cur.pm * tstepA + (size_t)(cur.kofs >> 1) * kpA; const char* cB = (const char*)g.Bt + (size_t)cur.pn * tstepB + (size_t)cur.kofs * kstep;
    S.a_ready(cur);
    if constexpr (SP2) {
        PG8_STAGE(PG8_SB(0, 0), cB, voffB); PG8_STAGE(PG8_SB(0, 1), cB + hstepB, voffB); PG8_STAGE(PG8_SA(0, 0), cA, voffA); PG8_STAGE(PG8_SA(0, 1), cA + hstepA, voffA);
        if (wr == 1) PG8_BAR;
        PG8_WAIT_V(2); PG8_BAR;
        PG8_STAGE(PG8_SB(1, 0), cB + kstep, voffB); PG8_STAGE(PG8_SA(1, 0), cA + kstep, voffA); PG8_STAGE(PG8_SB(1, 1), cB + hstepB + kstep, voffB);
        PG8_WAIT_V(6); PG8_BAR;
    } else {
        PG8_STAGE(PG8_SB(0, 0), cB, voffB); PG8_STAGE(PG8_SA(0, 0), cA, voffA); PG8_STAGE(PG8_SB(0, 1), cB + hstepB, voffB); PG8_STAGE(PG8_SA(0, 1), cA + hstepA, voffA);
        if (wr == 1) PG8_BAR;
        PG8_WAIT_V(4); PG8_BAR;
        PG8_STAGE(PG8_SB(1, 0), cB + kstep, voffB); PG8_STAGE(PG8_SA(1, 0), cA + kstep, voffA); PG8_STAGE(PG8_SB(1, 1), cB + hstepB + kstep, voffB);
        PG8_WAIT_V(6); PG8_BAR;
    }
    for (;;) {
        const bool has_next = S.next(ui + 1, nxt);
        const char* nA = has_next ? (const char*)g.A + (size_t)nxt.pm * tstepA + (size_t)(nxt.kofs >> 1) * kpA : cA; const char* nB = has_next ? (const char*)g.Bt + (size_t)nxt.pn * tstepB + (size_t)nxt.kofs * kstep : cB;
        const int nt = cur.nt ? cur.nt : nt_all;
        for (int t = 0; t < nt; t += 2) {
            const bool last = (t == nt - 2);
            const char* a1 = cA + (size_t)(t >> 1) * kpA + kstep;
            const char* a2 = last ? nA : cA + (size_t)((t >> 1) + 1) * kpA; const char* b2 = last ? nB : cB + (size_t)(t + 2) * kstep;
            const char* a3 = a2 + kstep; const char* b3 = b2 + kstep;
            if (last && has_next) S.a_ready(nxt);
            if constexpr (SP2) {
            PG8_LDB(B0, 0, 0); PG8_LDB(B1, 0, 1); PG8_SCHED; PG8_LDA(At, 0, 0); PG8_STAGE(PG8_SA(1, 1), a1 + hstepA, voffA);
            PG8_WAIT_V(8); PG8_WAIT_L(0); PG8_BAR; PG8_MMA(0, 0, At, B0); PG8_MMA(0, 1, At, B1); PG8_BAR; PG8_SCHED;
            PG8_LDA(At, 0, 1); PG8_STAGE(PG8_SB(0, 0), b2, voffB); PG8_STAGE(PG8_SB(0, 1), b2 + hstepB, voffB); PG8_STAGE(PG8_SA(0, 0), a2, voffA);
            PG8_WAIT_V(8); PG8_WAIT_L(0); PG8_BAR; PG8_MMA(1, 0, At, B0); PG8_MMA(1, 1, At, B1); PG8_BAR; PG8_SCHED;
            PG8_LDB(B0, 1, 0); PG8_LDB(B1, 1, 1); PG8_SCHED; PG8_LDA(At, 1, 0); PG8_STAGE(PG8_SA(0, 1), a2 + hstepA, voffA);
            PG8_WAIT_V(8); PG8_WAIT_L(0); PG8_BAR; PG8_MMA(0, 0, At, B0); PG8_MMA(0, 1, At, B1); PG8_BAR; PG8_SCHED;
            PG8_LDA(At, 1, 1); PG8_STAGE(PG8_SB(1, 0), b3, voffB); PG8_STAGE(PG8_SB(1, 1), b3 + hstepB, voffB); PG8_STAGE(PG8_SA(1, 0), a3, voffA);
            PG8_WAIT_V(8); PG8_WAIT_L(0); PG8_BAR; PG8_MMA(1, 0, At, B0); PG8_MMA(1, 1, At, B1); PG8_BAR; PG8_SCHED;
            } else {
            PG8_LDB(B0, 0, 0); PG8_SCHED; PG8_LDA(At, 0, 0); PG8_STAGE(PG8_SA(1, 1), a1 + hstepA, voffA);
            PG8_WAIT_L(8); PG8_BAR; PG8_WAIT_L(0); PG8_MMA(0, 0, At, B0); PG8_BAR; PG8_SCHED;
            PG8_LDB(B1, 0, 1); PG8_STAGE(PG8_SB(0, 0), b2, voffB);
            PG8_BAR; PG8_WAIT_L(0); PG8_MMA(0, 1, At, B1); PG8_BAR;
            PG8_LDA(At, 0, 1); PG8_STAGE(PG8_SA(0, 0), a2, voffA);
            PG8_BAR; PG8_WAIT_L(0); PG8_MMA(1, 0, At, B0); PG8_BAR; PG8_SCHED;
            PG8_STAGE(PG8_SB(0, 1), b2 + hstepB, voffB);
            PG8_WAIT_V(6); PG8_BAR; PG8_MMA(1, 1, At, B1); PG8_BAR;
            PG8_LDB(B0, 1, 0); PG8_SCHED; PG8_LDA(At, 1, 0); PG8_STAGE(PG8_SA(0, 1), a2 + hstepA, voffA);
            PG8_WAIT_L(8); PG8_BAR; PG8_WAIT_L(0); PG8_MMA(0, 0, At, B0); PG8_BAR; PG8_SCHED;
            PG8_LDB(B1, 1, 1); PG8_STAGE(PG8_SB(1, 0), b3, voffB);
            PG8_BAR; PG8_WAIT_L(0); PG8_MMA(0, 1, At, B1); PG8_BAR;
            PG8_LDA(At, 1, 1); PG8_STAGE(PG8_SA(1, 0), a3, voffA);
            PG8_BAR; PG8_WAIT_L(0); PG8_MMA(1, 0, At, B0); PG8_BAR; PG8_SCHED;
            PG8_STAGE(PG8_SB(1, 1), b3 + hstepB, voffB);
            PG8_WAIT_V(6); PG8_BAR; PG8_MMA(1, 1, At, B1); PG8_BAR;
            }
        }
        if constexpr (ALIGN_EPI) { if (wr == 0) PG8_BAR; }
        if constexpr (!Epi::AFTER_DRAIN) { E(acc, cur, wr, wc, fr, fq); S.done(cur); }
        if (!has_next) break;
#pragma unroll
        for (int a = 0; a < 2; ++a)
#pragma unroll
            for (int b = 0; b < 2; ++b)
#pragma unroll
                for (int m = 0; m < 4; ++m)
#pragma unroll
                    for (int n = 0; n < 2; ++n) acc[a][b][m][n] = (f32x4){0.f, 0.f, 0.f, 0.f};
        cur = nxt; cA = nA; cB = nB; ++ui;
        if constexpr (ALIGN_EPI) { if (wr == 1) PG8_BAR; }
    }
    PG8_WAIT_V(0);
    if constexpr (!ALIGN_EPI) { if (wr == 0) PG8_BAR; }
    PG8_BAR;
    if constexpr (Epi::AFTER_DRAIN) { E.fused(acc, cur, wr, wc, fr, fq, lds, wid, lane); S.done(cur); }
#undef PG8_SA
#undef PG8_SB
#undef PG8_STAGE
#undef PG8_LDA
#undef PG8_LDB
#undef PG8_MMA
#undef PG8_WAIT_V
#undef PG8_WAIT_L
#undef PG8_BAR
#undef PG8_SCHED
}
}


constexpr int DM = 1024, BP = 8, TP = 2064, NMETA = 16, BS = 128, TS = 8;
constexpr int NP = BP * TP;
constexpr int NS = BS * TS;
constexpr int NTOK = NP + NS;
constexpr int MROWS = NTOK + BS;
constexpr int PTOT = 8456, OFFB = 5128, PBW = 3328, DFF = 2816;
constexpr float ALPHA = 1.189207115002721f;
constexpr float LN_EPS = 1e-5f, GN_EPS_B = 64e-5f;
constexpr size_t O_YP = 0, O_YS = O_YP + (size_t)8 * 2048 * 1024, O_PC = O_YS + (size_t)128 * 8 * 1024, O_PN = O_PC + (size_t)8 * 4 * 128 * 256,
    O_PM = O_PN + 8 * 4 * 128, O_PS = O_PM + 32, O_PSH = O_PS + (size_t)8 * 16 * 4096, O_PCV = O_PSH + 8 * 1024, O_SC = O_PCV + 8 * 2 * 2816,
    O_SN = O_SC + (size_t)128 * 4 * 128 * 256, O_SM = O_SN + 128 * 4 * 128, O_SS = O_SM + 512, O_SSH = O_SS + (size_t)128 * 16 * 4096, O_SCV = O_SSH + 128 * 1024,
    O_END = O_SCV + (size_t)128 * 2 * 2816;
constexpr size_t MiB = 1u << 20;
constexpr size_t WS_CTL = 0, WS_IFG = 1 * MiB, WS_WUP = 2 * MiB, WS_WD = 13 * MiB, WS_XN = 18 * MiB + MiB / 2, WS_WO = 53 * MiB, WS_WIN = 55 * MiB,
    WS_PB = 71 * MiB + MiB / 2, WS_QKV = 183 * MiB + 5 * MiB / 8, WS_G1 = WS_PB, WS_PRE1 = WS_QKV, WS_UP = 66 * MiB + MiB / 4, WS_END = 256 * MiB;
static_assert(WS_WUP + (size_t)5632 * 1024 * 2 <= WS_WD && WS_WD + (size_t)1024 * 2816 * 2 <= WS_XN && WS_XN + (size_t)MROWS * 1024 * 2 <= WS_WO && WS_WO + (size_t)1024 * 1024 * 2 <= WS_WIN &&
              WS_WIN + (size_t)8448 * 1024 * 2 <= WS_PB && WS_PB + (size_t)MROWS * PBW * 2 <= WS_QKV && WS_QKV + (size_t)MROWS * 2048 * 2 <= WS_END && WS_G1 + (size_t)MROWS * 3072 * 2 <= WS_QKV &&
              WS_PRE1 + (size_t)MROWS * 1024 * 4 <= WS_END && WS_UP + (size_t)MROWS * 5632 * 2 <= WS_END && WS_UP >= WS_WO + (size_t)1024 * 1024 * 2, "d_ws map");
constexpr size_t OUT_ALG = 52 * MiB;
static_assert(OUT_ALG >= (size_t)MROWS * 3072 && OUT_ALG + (size_t)NTOK * 256 * 2 <= (size_t)O_PC * 4, "y-region staging");
constexpr int G1_SPLIT = 512;
constexpr size_t WS_PART = 56 * MiB;
constexpr int LDS_BYTES = 157696, LDS_CTL = LDS_BYTES - 256;

#define LAS __attribute__((address_space(3)))
typedef unsigned short bf16;
typedef unsigned v4u __attribute__((ext_vector_type(4)));
typedef unsigned v2u __attribute__((ext_vector_type(2)));
typedef float f32x4 __attribute__((ext_vector_type(4)));
typedef float f32x2 __attribute__((ext_vector_type(2)));
typedef short bf16x8 __attribute__((ext_vector_type(8)));
#define LDS_WAIT() asm volatile("s_waitcnt lgkmcnt(0)" ::: "memory")

__device__ __forceinline__ unsigned f2bf(float f) { unsigned u = __builtin_bit_cast(unsigned, f); return (u + 0x7fffu + ((u >> 16) & 1u)) >> 16; }
typedef __bf16 bf16x2_t __attribute__((ext_vector_type(2)));
__device__ __forceinline__ unsigned pk2(float lo, float hi) { f32x2 v = {lo, hi}; return __builtin_bit_cast(unsigned, __builtin_convertvector(v, bf16x2_t)); }
__device__ __forceinline__ float bflo(unsigned x) { return __builtin_bit_cast(float, x << 16); }
__device__ __forceinline__ float bfhi(unsigned x) { return __builtin_bit_cast(float, x & 0xffff0000u); }
__device__ __forceinline__ float bf2f(bf16 x) { return __builtin_bit_cast(float, (unsigned)x << 16); }
template <int CTRL> __device__ __forceinline__ float dppf(float x) { return __builtin_bit_cast(float, __builtin_amdgcn_update_dpp(0, __builtin_bit_cast(int, x), CTRL, 0xf, 0xf, false)); }
__device__ __forceinline__ float red8(float x) { x += dppf<0xB1>(x); x += dppf<0x4E>(x); x += dppf<0x141>(x); return x; }
__device__ __forceinline__ float red16(float x) { x += dppf<0xB1>(x); x += dppf<0x4E>(x); x += dppf<0x141>(x); x += dppf<0x140>(x); return x; }
__device__ __forceinline__ float wave_sum(float v) { v = red16(v); v += __shfl_xor(v, 16); v += __shfl_xor(v, 32); return v; }
template <int CTRL, int RMASK> __device__ __forceinline__ float dpp_id(float x, float ident) { return __builtin_bit_cast(float, __builtin_amdgcn_update_dpp(__builtin_bit_cast(int, ident), __builtin_bit_cast(int, x), CTRL, RMASK, 0xf, false)); }
__device__ __forceinline__ float wave_scan_sum(float x) {
    x += dpp_id<0x111, 0xf>(x, 0.f); x += dpp_id<0x112, 0xf>(x, 0.f); x += dpp_id<0x114, 0xf>(x, 0.f); x += dpp_id<0x118, 0xf>(x, 0.f);
    x += dpp_id<0x142, 0xa>(x, 0.f); x += dpp_id<0x143, 0xc>(x, 0.f); return x; }
__device__ __forceinline__ float wave_scan_max(float x) {
    const float ni = -__builtin_inff();
    x = fmaxf(x, dpp_id<0x111, 0xf>(x, ni)); x = fmaxf(x, dpp_id<0x112, 0xf>(x, ni)); x = fmaxf(x, dpp_id<0x114, 0xf>(x, ni)); x = fmaxf(x, dpp_id<0x118, 0xf>(x, ni));
    x = fmaxf(x, dpp_id<0x142, 0xa>(x, ni)); x = fmaxf(x, dpp_id<0x143, 0xc>(x, ni)); return x; }
__device__ __forceinline__ bf16 bf1(float x) { return (bf16)(pk2(x, x) & 0xffffu); }
__device__ __forceinline__ float sigmoidf_(float x) { return __builtin_amdgcn_rcpf(1.f + __expf(-x)); }
__device__ __forceinline__ float tanhf_(float x) { return 1.f - 2.f * __builtin_amdgcn_rcpf(__expf(2.f * x) + 1.f); }
__device__ __forceinline__ float softplusf_(float z) { return fmaxf(z, 0.f) + __logf(1.f + __expf(-fabsf(z))); }

struct Args { const float* in[34]; float* out; unsigned char* ws; };
enum { I_XP = 0, I_XS, I_MC, I_MN, I_MM, I_RS, I_RSH, I_FCV, I_META, I_LNG, I_LNB, I_WIN, I_BIF, I_MNG, I_MU, I_W0, I_W2, I_A0, I_A2, I_G2, I_KKS, I_KAS, I_RK, I_LXG, I_LXB,
       I_WOUT, I_L1G, I_L1B, I_WUP, I_CW, I_CB, I_WDN, I_L2G, I_L2B };

__device__ __forceinline__ void transpose_item(const float* W, int ldw, bf16* WT, int ldt, int k0, int src_n0, int dst_n0, LAS float* scr, int lane) {
    float tv[32];
#pragma unroll
    for (int i = 0; i < 32; ++i) tv[i] = W[(size_t)(k0 + 2 * i + (lane >> 5)) * ldw + src_n0 + (lane & 31)];
#pragma unroll
    for (int i = 0; i < 32; ++i) scr[(2 * i + (lane >> 5)) * 33 + (lane & 31)] = tv[i];
    LDS_WAIT(); asm volatile("" ::: "memory");
    const int c = lane & 7;
#pragma unroll
    for (int j = 0; j < 4; ++j) { const int n = (lane >> 3) + 8 * j; const LAS float* s = scr + (8 * c) * 33 + n;
        v4u o; o.x = pk2(s[0 * 33], s[1 * 33]); o.y = pk2(s[2 * 33], s[3 * 33]); o.z = pk2(s[4 * 33], s[5 * 33]); o.w = pk2(s[6 * 33], s[7 * 33]);
        *(v4u*)(WT + (size_t)(dst_n0 + n) * ldt + k0 + 8 * c) = o; }
    LDS_WAIT(); asm volatile("" ::: "memory");
}
__device__ __forceinline__ void weight_items(const Args& A, LAS unsigned char* lds, int part, int gw, int NGW, int wave, int lane) {
    unsigned char* ws = A.ws;
    bf16* WinT = (bf16*)(ws + WS_WIN); bf16* WoT = (bf16*)(ws + WS_WO); bf16* WupT = (bf16*)(ws + WS_WUP); bf16* WdT = (bf16*)(ws + WS_WD);
    LAS float* scr = (LAS float*)(lds + wave * 16384);
    constexpr int IA = 16 * 104, IB = 16 * 64, IC = 16 * 64, ID = 16 * 32, IE = 16 * 32, IF_ = 16 * 176, IG = 44 * 32;
    constexpr int N0 = IA + IB + IC + ID, N1 = IE + IF_ + IG;
    const float* w_in = A.in[I_WIN];
    for (int it = gw; it < (part ? N1 : N0); it += NGW) {
        int r = it + (part ? N0 : 0);
        if (r < IA) { const int kb = r / 104, nb = r % 104; transpose_item(w_in, PTOT, WinT, 1024, 64 * kb, OFFB + 32 * nb, 32 * nb, scr, lane); continue; } r -= IA;
        if (r < IB) { const int kb = r / 64, nb = r % 64; transpose_item(w_in, PTOT, WinT, 1024, 64 * kb, 2048 + 32 * nb, 3328 + 32 * nb, scr, lane); continue; } r -= IB;
        if (r < IC) { const int kb = r / 64, nb = r % 64; transpose_item(w_in, PTOT, WinT, 1024, 64 * kb, 32 * nb, 5376 + 32 * nb, scr, lane); continue; } r -= IC;
        if (r < ID) { const int kb = r / 32, nb = r % 32; transpose_item(w_in, PTOT, WinT, 1024, 64 * kb, 4096 + 32 * nb, 7424 + 32 * nb, scr, lane); continue; } r -= ID;
        if (r < IE) { const int kb = r / 32, nb = r % 32; transpose_item(A.in[I_WOUT], 1024, WoT, 1024, 64 * kb, 32 * nb, 32 * nb, scr, lane); continue; } r -= IE;
        if (r < IF_) { const int kb = r / 176, nb = r % 176; const int n0 = 32 * nb, j = n0 >> 8, c = n0 & 255; const int src = c < 128 ? 128 * j + c : DFF + 128 * j + (c - 128);
                       transpose_item(A.in[I_WUP], 2 * DFF, WupT, 1024, 64 * kb, src, n0, scr, lane); continue; } r -= IF_;
        { const int kb = r / 32, nb = r % 32; transpose_item(A.in[I_WDN], 1024, WdT, DFF, 64 * kb, 32 * nb, 32 * nb, scr, lane); }
    }
}
__device__ __forceinline__ void p0_prologue(const Args& A, LAS unsigned char* lds, int gw, int NGW, int wave, int lane, int tid, bool defer) {
    unsigned char* ws = A.ws;
    bf16* WinT = (bf16*)(ws + WS_WIN); bf16* WoT = (bf16*)(ws + WS_WO); bf16* WupT = (bf16*)(ws + WS_WUP); bf16* WdT = (bf16*)(ws + WS_WD); bf16* XN = (bf16*)(ws + WS_XN);
    float* IFG = (float*)(ws + WS_IFG);
    LAS float* scr = (LAS float*)(lds + wave * 16384);
    weight_items(A, lds, 0, gw, NGW, wave, lane);
    if (!defer) weight_items(A, lds, 1, gw, NGW, wave, lane);
    const float* w_in = A.in[I_WIN];
    __syncthreads();
    LAS float* wif = (LAS float*)lds;
    for (int i = tid; i < 8192; i += 512) { const int k = i >> 3, g = i & 7; wif[g * 1024 + k] = w_in[(size_t)k * PTOT + 5120 + g]; }
    __syncthreads();
    const float* lng = A.in[I_LNG]; const float* lnb = A.in[I_LNB]; const float* bif = A.in[I_BIF];
    f32x4 nx[4];
#define P0_LD(mm) do { const int m_ = (mm); const float* src_; \
        if (m_ < NP) { const int b_ = m_ / TP, t_ = m_ - b_ * TP; src_ = t_ < NMETA ? A.in[I_META] + (size_t)t_ * DM : A.in[I_XP] + ((size_t)b_ * 2048 + (t_ - NMETA)) * DM; } \
        else if (m_ < NTOK) src_ = A.in[I_XS] + (size_t)(m_ - NP) * DM; else src_ = A.in[I_RSH] + (size_t)(m_ - NTOK) * DM; \
        const f32x4* xr_ = (const f32x4*)src_ + lane; _Pragma("unroll") for (int j = 0; j < 4; ++j) nx[j] = xr_[64 * j]; } while (0)
    if (gw < MROWS) P0_LD(gw);
    for (int m = gw; m < MROWS; m += NGW) {
        float* shout = nullptr;
        if (m < NP) { const int b = m / TP, t = m - b * TP; if (t == TP - 1) shout = A.out + O_PSH + (size_t)b * DM; }
        else if (m < NTOK) { const int i = m - NP; if ((i & 7) == 7) shout = A.out + O_SSH + (size_t)(i >> 3) * DM; }
        f32x4 v[4];
#pragma unroll
        for (int j = 0; j < 4; ++j) v[j] = nx[j];
        if (m + NGW < MROWS) P0_LD(m + NGW);
        unsigned long long* o8 = (unsigned long long*)(XN + (size_t)m * DM) + lane;
        if (m < NTOK) {
            float s = 0.f;
#pragma unroll
            for (int j = 0; j < 4; ++j) s += (v[j].x + v[j].y) + (v[j].z + v[j].w);
            const float mean = wave_sum(s) * (1.f / DM); float s2 = 0.f;
#pragma unroll
            for (int j = 0; j < 4; ++j) { v[j] = v[j] - mean; s2 += (v[j].x * v[j].x + v[j].y * v[j].y) + (v[j].z * v[j].z + v[j].w * v[j].w); }
            const float rstd = __builtin_amdgcn_rsqf(wave_sum(s2) * (1.f / DM) + LN_EPS);
            float ga[8];
#pragma unroll
            for (int g = 0; g < 8; ++g) ga[g] = 0.f;
#pragma unroll
            for (int j = 0; j < 4; ++j) { const f32x4 gg = ((const f32x4*)lng)[lane + 64 * j], bb = ((const f32x4*)lnb)[lane + 64 * j]; v[j] = v[j] * rstd * gg + bb;
#pragma unroll
                for (int g = 0; g < 8; ++g) { const f32x4 w = *(const LAS f32x4*)(wif + g * 1024 + 256 * j + 4 * lane); ga[g] += (v[j].x * w.x + v[j].y * w.y) + (v[j].z * w.z + v[j].w * w.w); } }
#pragma unroll
            for (int g = 0; g < 8; ++g) ga[g] = wave_sum(ga[g]);
            if (lane < 8) { float val = ga[0];
#pragma unroll
                for (int g = 1; g < 8; ++g) val = lane == g ? ga[g] : val;
                IFG[(size_t)m * 8 + lane] = val + bif[lane]; }
            if (shout) {
#pragma unroll
                for (int j = 0; j < 4; ++j) ((f32x4*)shout)[lane + 64 * j] = v[j]; }
        }
#pragma unroll
        for (int j = 0; j < 4; ++j) o8[64 * j] = (unsigned long long)pk2(v[j].x, v[j].y) | ((unsigned long long)pk2(v[j].z, v[j].w) << 32);
    }
}


__device__ __forceinline__ void lora_act_pass(const Args& A, int gtid, int nthr) {
    const bf16* PB = (const bf16*)(A.ws + WS_PB); bf16* ALG = (bf16*)((unsigned char*)A.out + OUT_ALG); const float* mu = A.in[I_MU] + 3072;
    for (int it = gtid; it < NTOK * 32; it += nthr) {
        const int m = it >> 5, j = it & 31;
        int prow;
        if (m < NP) { const int t = m % TP; prow = t == 0 ? -1 : m - 1; } else { const int i = m - NP; prow = (i & 7) == 0 ? NTOK + (i >> 3) : m - 1; }
        const v4u lc = *(const v4u*)(PB + (size_t)m * PBW + 3072 + 8 * j); v4u lp = (v4u){0u, 0u, 0u, 0u};
        if (prow >= 0) lp = *(const v4u*)(PB + (size_t)prow * PBW + 3072 + 8 * j);
        const f32x4 m0 = *(const f32x4*)(mu + 8 * j), m1 = *(const f32x4*)(mu + 8 * j + 4); float ev[8];
        ev[0] = bflo(lc.x) + (bflo(lp.x) - bflo(lc.x)) * m0.x; ev[1] = bfhi(lc.x) + (bfhi(lp.x) - bfhi(lc.x)) * m0.y;
        ev[2] = bflo(lc.y) + (bflo(lp.y) - bflo(lc.y)) * m0.z; ev[3] = bfhi(lc.y) + (bfhi(lp.y) - bfhi(lc.y)) * m0.w;
        ev[4] = bflo(lc.z) + (bflo(lp.z) - bflo(lc.z)) * m1.x; ev[5] = bfhi(lc.z) + (bfhi(lp.z) - bfhi(lc.z)) * m1.y;
        ev[6] = bflo(lc.w) + (bflo(lp.w) - bflo(lc.w)) * m1.z; ev[7] = bfhi(lc.w) + (bfhi(lp.w) - bfhi(lc.w)) * m1.w;
        if (j < 8) {
#pragma unroll
            for (int i = 0; i < 8; ++i) ev[i] = tanhf_(ev[i]); }
        else if (j >= 16) {
#pragma unroll
            for (int i = 0; i < 8; ++i) ev[i] = sigmoidf_(ev[i]); }
        v4u o; o.x = pk2(ev[0], ev[1]); o.y = pk2(ev[2], ev[3]); o.z = pk2(ev[4], ev[5]); o.w = pk2(ev[6], ev[7]);
        *(v4u*)(ALG + (size_t)m * 256 + 8 * j) = o;
    }
}
constexpr int RW_RAWR = 0;
constexpr int RW_AL = 6656;
constexpr int RW_AA = RW_AL + 16 * 264 * 2;
constexpr int RW_EP = RW_AA + 4096;
constexpr int RW_EN = RW_EP + 4096;
constexpr int RW_RF = RW_EN + 4096;
constexpr int RW_KF = RW_RF + 4096;
constexpr int RW_CD = RW_KF + 4096;
constexpr int R64 = 72, R32 = 40;
constexpr int RW_YF = RW_CD + 16 * R32 * 2;
constexpr int RW_VEC = RW_YF + 16 * 68 * 4;
constexpr int VC_NB = 256, VC_AKT = VC_NB + 16 * 72 * 2, VC_AN2 = VC_AKT + 64 * 40 * 2, VC_CDN = VC_AN2 + 1024;
constexpr int RW_VEC_SZ = VC_CDN + 16 * 40 * 2;
constexpr int RW_TRI = RW_VEC + 2 * RW_VEC_SZ;
constexpr int TR_G = 4096, TR_BON = TR_G + 16 * 68 * 4, TR_RB = TR_BON + 64, TR_AB = TR_RB + 2304, TR_KB = TR_AB + 2304, TR_UVT = TR_KB + 2304;
constexpr int RW_TRI_SZ = TR_UVT + 64 * 40 * 2;
constexpr int RW_S0 = RW_TRI + 3 * RW_TRI_SZ;
constexpr int S0_SZ = 64 * 72 * 2;
constexpr int RW_S0L = RW_S0 + 2 * S0_SZ;
constexpr int RW_WT = RW_S0L + S0_SZ;
constexpr int RW_END = RW_WT + 64 * 20 * 4;
static_assert(RW_AL % 16 == 0 && RW_AA % 16 == 0 && RW_CD % 16 == 0 && RW_VEC % 16 == 0 && RW_VEC_SZ % 16 == 0 && RW_TRI % 16 == 0 && RW_TRI_SZ % 16 == 0 && RW_S0 % 16 == 0 && RW_END <= LDS_CTL, "rwkv lds");
__device__ __forceinline__ float frcp(float x) { return __builtin_amdgcn_rcpf(x); }
__device__ __forceinline__ float fsigm(float x) { return frcp(1.f + __expf(-x)); }
__device__ __forceinline__ float ftanh(float x) { return 1.f - 2.f * frcp(__expf(2.f * x) + 1.f); }
#define RW_BAR() do { asm volatile("s_waitcnt lgkmcnt(0)" ::: "memory"); __builtin_amdgcn_s_barrier(); asm volatile("" ::: "memory"); } while (0)

template <bool PROMPT> __device__ __forceinline__ void rwkv_item(const Args& A, LAS unsigned char* lds, int b0, int nseq, int h, int tid, int wid, int lane, bool dostore = true) {
    const bf16* PB = (const bf16*)(A.ws + WS_PB); const bf16* ALG = (const bf16*)((const unsigned char*)A.out + OUT_ALG);
    bf16* HB = (bf16*)(A.ws + WS_PB);
    constexpr int T = PROMPT ? TP : TS, NST = PROMPT ? 16 : 8, NCH = (T + 15) / 16, SPB = NST / 4;
    const int NE = nseq * NCH;
    if (wid < 4) {
        const int fr = lane & 15, fq = lane >> 4, w = wid;
        const int sv = tid >> 2, sj = tid & 3;
        const int stok = tid >> 4, scq = tid & 15, sch4 = 64 * h + 4 * scq;
        const f32x4 slxg4 = *(const f32x4*)(A.in[I_LXG] + sch4), slxb4 = *(const f32x4*)(A.in[I_LXB] + sch4);
        LAS bf16* CD = (LAS bf16*)(lds + RW_CD); LAS float* YF = (LAS float*)(lds + RW_YF);
        f32x4 accS[4], sx[4], sy[4];
#pragma unroll
        for (int j = 0; j < 4; ++j) sx[j] = (f32x4){0.f, 0.f, 0.f, 0.f};
        auto load_state = [&](int b) { const float* sp = A.in[I_RS] + (size_t)(b * 16 + h) * 4096;
#pragma unroll
            for (int kt = 0; kt < 4; ++kt)
#pragma unroll
                for (int r = 0; r < 4; ++r) sx[kt][r] = sp[(16 * w + 4 * fq + r) * 64 + 16 * kt + fr]; };
        if (!PROMPT) load_state(b0);
#pragma unroll
        for (int j = 0; j < 4; ++j) sy[j] = sx[j];
        for (int i = -1; i <= NE; ++i) {
            if (i >= 0 && i < NE) {
                const int sq = i / NCH, c = i - sq * NCH, b = b0 + sq;
                if (c == 0) {
#pragma unroll
                    for (int j = 0; j < 4; ++j) accS[j] = sy[j];
                    if (!PROMPT && sq + 1 < nseq) load_state(b + 1);
                }
                const LAS unsigned char* vc = lds + RW_VEC + (i & 1) * RW_VEC_SZ; const LAS float* PWv = (const LAS float*)vc; const LAS bf16* NB = (const LAS bf16*)(vc + VC_NB);
                const LAS bf16* AKT = (const LAS bf16*)(vc + VC_AKT); const LAS float* AN2 = (const LAS float*)(vc + VC_AN2); const LAS bf16* CDN = (const LAS bf16*)(vc + VC_CDN);
                LAS bf16* UVT = (LAS bf16*)(lds + RW_TRI + (i % 3) * RW_TRI_SZ + TR_UVT);
                LAS bf16* S0h = (LAS bf16*)(lds + RW_S0 + (i & 1) * S0_SZ); LAS bf16* S0l = (LAS bf16*)(lds + RW_S0L); LAS float* WT = (LAS float*)(lds + RW_WT);
                const int ep = i - 1; const LAS unsigned char* trp = lds + RW_TRI + ((ep < 0 ? 0 : ep) % 3) * RW_TRI_SZ;
                if (i >= 1 && w < 2) {
                    const LAS bf16* Xb = (const LAS bf16*)(trp + (w == 0 ? TR_AB : TR_KB)); const LAS bf16* Rb = (const LAS bf16*)(trp + TR_RB);
                    f32x4 d = (f32x4){0.f, 0.f, 0.f, 0.f};
#pragma unroll
                    for (int ks = 0; ks < 2; ++ks) d = __builtin_amdgcn_mfma_f32_16x16x32_bf16(*(const LAS bf16x8*)(Xb + fr * R64 + 32 * ks + 8 * fq), *(const LAS bf16x8*)(Rb + fr * R64 + 32 * ks + 8 * fq), d, 0, 0, 0);
                    v2u cw; cw.x = pk2(4 * fq + 0 <= fr ? d[0] : 0.f, 4 * fq + 1 <= fr ? d[1] : 0.f); cw.y = pk2(4 * fq + 2 <= fr ? d[2] : 0.f, 4 * fq + 3 <= fr ? d[3] : 0.f);
                    *(LAS v2u*)(CD + fr * R32 + 16 * w + 4 * fq) = cw;
                }
                if (w >= 2) {
                    const LAS bf16* Xb = (const LAS bf16*)(lds + RW_TRI + (i % 3) * RW_TRI_SZ + ((w == 2) ? TR_AB : TR_KB)); LAS float* AN2w = (LAS float*)(lds + RW_VEC + (i & 1) * RW_VEC_SZ + VC_AN2); LAS bf16* CDNw = (LAS bf16*)(lds + RW_VEC + (i & 1) * RW_VEC_SZ + VC_CDN);
                    f32x4 d = (f32x4){0.f, 0.f, 0.f, 0.f};
#pragma unroll
                    for (int ks = 0; ks < 2; ++ks) d = __builtin_amdgcn_mfma_f32_16x16x32_bf16(*(const LAS bf16x8*)(Xb + fr * R64 + 32 * ks + 8 * fq), *(const LAS bf16x8*)(NB + fr * R64 + 32 * ks + 8 * fq), d, 0, 0, 0);
                    if (w == 2) {
#pragma unroll
                        for (int r = 0; r < 4; ++r) AN2w[(fr * 4 + r) * 4 + fq] = (4 * fq + r < fr) ? d[r] : 0.f;
                    } else {
                        v2u wz; wz.x = 0u; wz.y = 0u; *(LAS v2u*)(CDNw + fr * R32 + 4 * fq) = wz;
                        v2u cw2; cw2.x = pk2(4 * fq + 0 < fr ? d[0] : 0.f, 4 * fq + 1 < fr ? d[1] : 0.f); cw2.y = pk2(4 * fq + 2 < fr ? d[2] : 0.f, 4 * fq + 3 < fr ? d[3] : 0.f);
                        *(LAS v2u*)(CDNw + fr * R32 + 16 + 4 * fq) = cw2;
                    }
                }
#pragma unroll
                for (int kt = 0; kt < 4; ++kt)
#pragma unroll
                    for (int r = 0; r < 4; r += 2) {
                        const float x0 = accS[kt][r], x1 = accS[kt][r + 1]; const unsigned hi2 = pk2(x0, x1); const unsigned lo2 = pk2(x0 - bflo(hi2), x1 - bfhi(hi2));
                        const int o = (16 * w + 4 * fq + r) * R64 + 16 * kt + fr;
                        S0h[o] = (bf16)(hi2 & 0xffffu); S0h[o + R64] = (bf16)(hi2 >> 16); S0l[o] = (bf16)(lo2 & 0xffffu); S0l[o + R64] = (bf16)(lo2 >> 16); }
                RW_BAR();
                if (i >= 1) {
                    const LAS bf16* Rb = (const LAS bf16*)(trp + TR_RB); const LAS bf16* S0 = (const LAS bf16*)(lds + RW_S0 + (ep & 1) * S0_SZ); const LAS bf16* UVp = (const LAS bf16*)(trp + TR_UVT);
                    f32x4 d = (f32x4){0.f, 0.f, 0.f, 0.f};
#pragma unroll
                    for (int ks = 0; ks < 2; ++ks) d = __builtin_amdgcn_mfma_f32_16x16x32_bf16(*(const LAS bf16x8*)(Rb + fr * R64 + 32 * ks + 8 * fq), *(const LAS bf16x8*)(S0 + (16 * w + fr) * R64 + 32 * ks + 8 * fq), d, 0, 0, 0);
                    d = __builtin_amdgcn_mfma_f32_16x16x32_bf16(*(const LAS bf16x8*)(CD + fr * R32 + 8 * fq), *(const LAS bf16x8*)(UVp + (16 * w + fr) * R32 + 8 * (fq ^ (fr >> 2))), d, 0, 0, 0);
#pragma unroll
                    for (int r = 0; r < 4; ++r) YF[(4 * fq + r) * 68 + 16 * w + fr] = d[r];
                }
                {
                    f32x4 d = (f32x4){0.f, 0.f, 0.f, 0.f};
#pragma unroll
                    for (int ks = 0; ks < 2; ++ks) { const bf16x8 a = *(const LAS bf16x8*)(NB + fr * R64 + 32 * ks + 8 * fq);
                        d = __builtin_amdgcn_mfma_f32_16x16x32_bf16(a, *(const LAS bf16x8*)(S0h + (16 * w + fr) * R64 + 32 * ks + 8 * fq), d, 0, 0, 0);
                        d = __builtin_amdgcn_mfma_f32_16x16x32_bf16(a, *(const LAS bf16x8*)(S0l + (16 * w + fr) * R64 + 32 * ks + 8 * fq), d, 0, 0, 0); }
                    d = __builtin_amdgcn_mfma_f32_16x16x32_bf16(*(const LAS bf16x8*)(CDN + fr * R32 + 8 * fq), *(const LAS bf16x8*)(UVT + (16 * w + fr) * R32 + 8 * (fq ^ (fr >> 2))), d, 0, 0, 0);
                    *(LAS f32x4*)(WT + (16 * w + fr) * 20 + 4 * fq) = d;
                }
                RW_BAR();
                {
                    const f32x4 w0 = *(const LAS f32x4*)(WT + sv * 20), w1 = *(const LAS f32x4*)(WT + sv * 20 + 4), w2 = *(const LAS f32x4*)(WT + sv * 20 + 8), w3 = *(const LAS f32x4*)(WT + sv * 20 + 12);
                    const float wv[16] = {w0.x, w0.y, w0.z, w0.w, w1.x, w1.y, w1.z, w1.w, w2.x, w2.y, w2.z, w2.w, w3.x, w3.y, w3.z, w3.w};
                    float u[4] = {0.f, 0.f, 0.f, 0.f};
#pragma unroll
                    for (int t = 0; t < 16; ++t) {
                        const f32x4 cf = *(const LAS f32x4*)(AN2 + (t * 4 + sj) * 4);
                        float p = (u[0] * cf.x + u[1] * cf.y) + (u[2] * cf.z + u[3] * cf.w);
                        p += dppf<0xB1>(p); p += dppf<0x4E>(p);
                        const float ut = wv[t] + p;
                        if (sj == (t & 3)) u[t >> 2] = ut;
                    }
#pragma unroll
                    for (int m2 = 0; m2 < 4; ++m2) { const int ii = 4 * m2 + sj; UVT[sv * R32 + 8 * ((ii >> 3) ^ ((sv >> 2) & 3)) + (ii & 7)] = (bf16)(pk2(u[m2], u[m2]) & 0xffffu); }
                }
                RW_BAR();
                if (i >= 1 && stok < NST) {
                    const int sq = ep / NCH, c = ep - sq * NCH, b = b0 + sq; const int row0 = PROMPT ? b * TP : NP + b * TS;
                    const int o = stok * 64 + 4 * scq; const f32x4 y4 = *(const LAS f32x4*)(YF + stok * 68 + 4 * scq);
                    const float mean = red16((y4.x + y4.y) + (y4.z + y4.w)) * (1.f / 64.f); const f32x4 d = y4 - mean;
                    const float var = red16((d.x * d.x + d.y * d.y) + (d.z * d.z + d.w * d.w)) * (1.f / 64.f); const float rstd = __builtin_amdgcn_rsqf(var + GN_EPS_B);
                    const f32x4 v4 = *(const LAS f32x4*)((const LAS float*)trp + o), g4 = *(const LAS f32x4*)((const LAS float*)(trp + TR_G) + stok * 68 + 4 * scq); const float bon = ((const LAS float*)(trp + TR_BON))[stok];
                    const f32x4 ov = (d * rstd * slxg4 + slxb4 + bon * v4) * g4;
                    v2u w; w.x = pk2(ov.x, ov.y); w.y = pk2(ov.z, ov.w);
                    if (dostore) *(v2u*)(HB + (size_t)(row0 + 16 * c + stok) * PBW + sch4) = w;
                }
#pragma unroll
                for (int kt = 0; kt < 4; ++kt) {
                    f32x4 d = __builtin_amdgcn_mfma_f32_16x16x32_bf16(*(const LAS bf16x8*)(UVT + (16 * w + fr) * R32 + 8 * (fq ^ (fr >> 2))), *(const LAS bf16x8*)(AKT + (16 * kt + fr) * R32 + 8 * (fq ^ (fr >> 2))), accS[kt], 0, 0, 0);
                    accS[kt] = d * PWv[16 * kt + fr];
                }
                if (c == NCH - 1) {
#pragma unroll
                    for (int j = 0; j < 4; ++j) sy[j] = sx[j];
                    asm volatile("" : "+v"(sy[0]), "+v"(sy[1]), "+v"(sy[2]), "+v"(sy[3]));
                    float* so = A.out + (PROMPT ? O_PS : O_SS) + (size_t)(b * 16 + h) * 4096;
#pragma unroll
                    for (int kt = 0; kt < 4; ++kt)
#pragma unroll
                        for (int r = 0; r < 4; ++r) so[(16 * w + 4 * fq + r) * 64 + 16 * kt + fr] = accS[kt][r];
                }
                RW_BAR();
            } else {
                const int ep = i - 1; const LAS unsigned char* trp = lds + RW_TRI + ((ep < 0 ? 0 : ep) % 3) * RW_TRI_SZ;
                if (i >= 1 && w < 2) {
                    const LAS bf16* Xb = (const LAS bf16*)(trp + (w == 0 ? TR_AB : TR_KB)); const LAS bf16* Rb = (const LAS bf16*)(trp + TR_RB);
                    f32x4 d = (f32x4){0.f, 0.f, 0.f, 0.f};
#pragma unroll
                    for (int ks = 0; ks < 2; ++ks) d = __builtin_amdgcn_mfma_f32_16x16x32_bf16(*(const LAS bf16x8*)(Xb + fr * R64 + 32 * ks + 8 * fq), *(const LAS bf16x8*)(Rb + fr * R64 + 32 * ks + 8 * fq), d, 0, 0, 0);
                    v2u cw; cw.x = pk2(4 * fq + 0 <= fr ? d[0] : 0.f, 4 * fq + 1 <= fr ? d[1] : 0.f); cw.y = pk2(4 * fq + 2 <= fr ? d[2] : 0.f, 4 * fq + 3 <= fr ? d[3] : 0.f);
                    *(LAS v2u*)(CD + fr * R32 + 16 * w + 4 * fq) = cw;
                }
                RW_BAR();
                if (i >= 1) {
                    const LAS bf16* Rb = (const LAS bf16*)(trp + TR_RB); const LAS bf16* S0 = (const LAS bf16*)(lds + RW_S0 + (ep & 1) * S0_SZ); const LAS bf16* UVp = (const LAS bf16*)(trp + TR_UVT);
                    f32x4 d = (f32x4){0.f, 0.f, 0.f, 0.f};
#pragma unroll
                    for (int ks = 0; ks < 2; ++ks) d = __builtin_amdgcn_mfma_f32_16x16x32_bf16(*(const LAS bf16x8*)(Rb + fr * R64 + 32 * ks + 8 * fq), *(const LAS bf16x8*)(S0 + (16 * w + fr) * R64 + 32 * ks + 8 * fq), d, 0, 0, 0);
                    d = __builtin_amdgcn_mfma_f32_16x16x32_bf16(*(const LAS bf16x8*)(CD + fr * R32 + 8 * fq), *(const LAS bf16x8*)(UVp + (16 * w + fr) * R32 + 8 * (fq ^ (fr >> 2))), d, 0, 0, 0);
#pragma unroll
                    for (int r = 0; r < 4; ++r) YF[(4 * fq + r) * 68 + 16 * w + fr] = d[r];
                }
                RW_BAR(); RW_BAR();
                if (i >= 1 && stok < NST) {
                    const int sq = ep / NCH, c = ep - sq * NCH, b = b0 + sq; const int row0 = PROMPT ? b * TP : NP + b * TS;
                    const int o = stok * 64 + 4 * scq; const f32x4 y4 = *(const LAS f32x4*)(YF + stok * 68 + 4 * scq);
                    const float mean = red16((y4.x + y4.y) + (y4.z + y4.w)) * (1.f / 64.f); const f32x4 d = y4 - mean;
                    const float var = red16((d.x * d.x + d.y * d.y) + (d.z * d.z + d.w * d.w)) * (1.f / 64.f); const float rstd = __builtin_amdgcn_rsqf(var + GN_EPS_B);
                    const f32x4 v4 = *(const LAS f32x4*)((const LAS float*)trp + o), g4 = *(const LAS f32x4*)((const LAS float*)(trp + TR_G) + stok * 68 + 4 * scq); const float bon = ((const LAS float*)(trp + TR_BON))[stok];
                    const f32x4 ov = (d * rstd * slxg4 + slxb4 + bon * v4) * g4;
                    v2u w; w.x = pk2(ov.x, ov.y); w.y = pk2(ov.z, ov.w);
                    if (dostore) *(v2u*)(HB + (size_t)(row0 + 16 * c + stok) * PBW + sch4) = w;
                }
                RW_BAR();
            }
        }
    } else {
        const int p = tid - 256, pw = wid - 4, fr = lane & 15, fq = lane >> 4;
        const int tok = p >> 4, cq = p & 15;
        LAS bf16* rawr = (LAS bf16*)(lds + RW_RAWR); LAS bf16* AL = (LAS bf16*)(lds + RW_AL); LAS float* Aa = (LAS float*)(lds + RW_AA); LAS float* EP = (LAS float*)(lds + RW_EP); LAS float* EN = (LAS float*)(lds + RW_EN);
        LAS float* Rr = (LAS float*)(lds + RW_RF); LAS bf16* CD = (LAS bf16*)(lds + RW_CD); LAS float* YF = (LAS float*)(lds + RW_YF);
        const int ch4 = 64 * h + 4 * cq;
        const f32x4 kks4 = *(const f32x4*)(A.in[I_KKS] + ch4), kas4 = *(const f32x4*)(A.in[I_KAS] + ch4), rk4 = *(const f32x4*)(A.in[I_RK] + ch4);
        const f32x4 lxg4 = *(const f32x4*)(A.in[I_LXG] + ch4), lxb4 = *(const f32x4*)(A.in[I_LXB] + ch4);
        const f32x4 mur = *(const f32x4*)(A.in[I_MU] + ch4), muk = *(const f32x4*)(A.in[I_MU] + 1024 + ch4), muv = *(const f32x4*)(A.in[I_MU] + 2048 + ch4);
        const int chm = 64 * h + 16 * pw + fr;
        const float w0c = A.in[I_W0][chm], a0c = A.in[I_A0][chm];
        bf16x8 bw[8];
        {
            const float* w2 = A.in[I_W2]; const float* a2 = A.in[I_A2]; const float* g2 = A.in[I_G2];
#pragma unroll
            for (int s = 0; s < 8; ++s) {
                const float* src = s < 2 ? w2 + (size_t)(32 * s + 8 * fq) * 1024 + chm : (s < 4 ? a2 + (size_t)(32 * (s - 2) + 8 * fq) * 1024 + chm : g2 + (size_t)(32 * (s - 4) + 8 * fq) * 1024 + chm);
#pragma unroll
                for (int j = 0; j < 8; ++j) bw[s][j] = (short)f2bf(src[(size_t)j * 1024]);
            }
        }
        v4u pfr0, pfr1, pfl0, pfl1; bf16 ppv0 = 0;
        const int q0 = p, q1 = p + 256;
        const int t0r = q0 / 24, rem0 = q0 - t0r * 24, t1r = q1 / 24, rem1 = q1 - t1r * 24;
        auto prefetch = [&](int e) {
            const int sq = e / NCH, c = e - sq * NCH, b = b0 + sq; const int row0 = PROMPT ? b * TP : NP + b * TS; const int tb = 16 * c;
            pfr0 = (v4u){0u, 0u, 0u, 0u}; pfr1 = pfr0; pfl0 = pfr0; pfl1 = pfr0;
            if (tb + t0r < T) pfr0 = *(const v4u*)(PB + (size_t)(row0 + tb + t0r) * PBW + (rem0 >> 3) * 1024 + 64 * h + (rem0 & 7) * 8);
            if (q1 < 384 && tb + t1r < T) pfr1 = *(const v4u*)(PB + (size_t)(row0 + tb + t1r) * PBW + (rem1 >> 3) * 1024 + 64 * h + (rem1 & 7) * 8);
            if (tb + (p >> 5) < T) pfl0 = *(const v4u*)(ALG + (size_t)(row0 + tb + (p >> 5)) * 256 + (p & 31) * 8);
            if (tb + 8 + (p >> 5) < T) pfl1 = *(const v4u*)(ALG + (size_t)(row0 + tb + 8 + (p >> 5)) * 256 + (p & 31) * 8);
            if (!PROMPT && c == 0) { const bf16* prow = PB + (size_t)(NTOK + b) * PBW;
                if (p < 192) ppv0 = prow[(p >> 6) * 1024 + 64 * h + (p & 63)]; }
        };
        prefetch(0);
#pragma unroll
        for (int z = 0; z < 3; ++z) { LAS v4u* zp = (LAS v4u*)(lds + RW_TRI + z * RW_TRI_SZ + TR_UVT); zp[p] = (v4u){0u, 0u, 0u, 0u}; if (p < 64) zp[256 + p] = (v4u){0u, 0u, 0u, 0u}; }
        for (int i = -1; i <= NE; ++i) {
            const int e = i + 1; const bool doprep = e < NE;
            LAS unsigned char* vcb = lds + RW_VEC + (e & 1) * RW_VEC_SZ; LAS float* PWv = (LAS float*)vcb; LAS bf16* NB = (LAS bf16*)(vcb + VC_NB); LAS bf16* AKT = (LAS bf16*)(vcb + VC_AKT);
            LAS float* AN2 = (LAS float*)(vcb + VC_AN2); LAS bf16* CDN = (LAS bf16*)(vcb + VC_CDN); LAS float* Kp = (LAS float*)(lds + RW_KF);
            LAS unsigned char* trb = lds + RW_TRI + (e % 3) * RW_TRI_SZ; LAS float* Vv = (LAS float*)trb; LAS float* Gg = (LAS float*)(trb + TR_G); LAS float* BON = (LAS float*)(trb + TR_BON);
            LAS bf16* RB = (LAS bf16*)(trb + TR_RB); LAS bf16* AB = (LAS bf16*)(trb + TR_AB); LAS bf16* KB = (LAS bf16*)(trb + TR_KB); LAS bf16* UVT = (LAS bf16*)(trb + TR_UVT);
            const int ep = i - 1;
            const LAS unsigned char* trp = lds + RW_TRI + ((ep < 0 ? 0 : ep) % 3) * RW_TRI_SZ;
#define RW_REGS_TO_LDS(ee) do { \
                *(LAS v4u*)(rawr + (t0r + 1) * 192 + (rem0 >> 3) * 64 + (rem0 & 7) * 8) = pfr0; \
                if (q1 < 384) *(LAS v4u*)(rawr + (t1r + 1) * 192 + (rem1 >> 3) * 64 + (rem1 & 7) * 8) = pfr1; \
                *(LAS v4u*)(AL + (p >> 5) * 264 + (p & 31) * 8) = pfl0; *(LAS v4u*)(AL + ((p >> 5) + 8) * 264 + (p & 31) * 8) = pfl1; \
                if ((ee) % NCH == 0) { if (p < 192) rawr[p] = PROMPT ? (bf16)0 : ppv0; } } while (0)
            if (doprep) {
                RW_REGS_TO_LDS(e);
                if (e + 1 < NE) prefetch(e + 1);
            }
            RW_BAR();
            if (doprep) {
                const LAS v2u* rc = (const LAS v2u*)(rawr + (tok + 1) * 192 + 4 * cq); const LAS v2u* rp = (const LAS v2u*)(rawr + tok * 192 + 4 * cq);
                const v2u c0 = rc[0], c1 = rc[16], c2 = rc[32], p0 = rp[0], p1 = rp[16], p2 = rp[32];
                f32x4 x;
                x.x = bflo(c0.x) + (bflo(p0.x) - bflo(c0.x)) * mur.x; x.y = bfhi(c0.x) + (bfhi(p0.x) - bfhi(c0.x)) * mur.y; x.z = bflo(c0.y) + (bflo(p0.y) - bflo(c0.y)) * mur.z; x.w = bfhi(c0.y) + (bfhi(p0.y) - bfhi(c0.y)) * mur.w;
                *(LAS f32x4*)(Rr + tok * 64 + 4 * cq) = x;
                x.x = bflo(c1.x) + (bflo(p1.x) - bflo(c1.x)) * muk.x; x.y = bfhi(c1.x) + (bfhi(p1.x) - bfhi(c1.x)) * muk.y; x.z = bflo(c1.y) + (bflo(p1.y) - bflo(c1.y)) * muk.z; x.w = bfhi(c1.y) + (bfhi(p1.y) - bfhi(c1.y)) * muk.w;
                *(LAS f32x4*)(Kp + tok * 64 + 4 * cq) = x;
                x.x = bflo(c2.x) + (bflo(p2.x) - bflo(c2.x)) * muv.x; x.y = bfhi(c2.x) + (bfhi(p2.x) - bfhi(c2.x)) * muv.y; x.z = bflo(c2.y) + (bflo(p2.y) - bflo(c2.y)) * muv.z; x.w = bfhi(c2.y) + (bfhi(p2.y) - bfhi(c2.y)) * muv.w;
                *(LAS f32x4*)(Vv + tok * 64 + 4 * cq) = x;
                { const unsigned v01 = pk2(x.x, x.y), v23 = pk2(x.z, x.w); LAS bf16* vt = UVT + (4 * cq) * R32 + 8 * ((2 + (tok >> 3)) ^ (cq & 3)) + (tok & 7);
                  vt[0] = (bf16)(v01 & 0xffffu); vt[R32] = (bf16)(v01 >> 16); vt[2 * R32] = (bf16)(v23 & 0xffffu); vt[3 * R32] = (bf16)(v23 >> 16); }
            }
            RW_BAR();
            if (doprep) {
                if (PROMPT) { if (p < 192) rawr[p] = rawr[16 * 192 + p]; }
                f32x4 d0 = (f32x4){0.f, 0.f, 0.f, 0.f}, d1 = d0, d2 = d0;
                const LAS bf16* ar = AL + fr * 264 + 8 * fq;
#pragma unroll
                for (int s = 0; s < 2; ++s) { d0 = __builtin_amdgcn_mfma_f32_16x16x32_bf16(*(const LAS bf16x8*)(ar + 32 * s), bw[s], d0, 0, 0, 0);
                                              d1 = __builtin_amdgcn_mfma_f32_16x16x32_bf16(*(const LAS bf16x8*)(ar + 64 + 32 * s), bw[2 + s], d1, 0, 0, 0); }
#pragma unroll
                for (int s = 0; s < 4; ++s) d2 = __builtin_amdgcn_mfma_f32_16x16x32_bf16(*(const LAS bf16x8*)(ar + 128 + 32 * s), bw[4 + s], d2, 0, 0, 0);
                float lw[4];
#pragma unroll
                for (int r = 0; r < 4; ++r) lw[r] = -0.6065306597126334f * fsigm(w0c + d0[r]);
                lw[1] += lw[0]; lw[2] += lw[1]; lw[3] += lw[2];
                { const float t4 = lw[3]; const float x1 = __shfl_up(t4, 16), x2 = __shfl_up(t4, 32), x3 = __shfl_up(t4, 48);
                  const float base = (fq >= 1 ? x1 : 0.f) + (fq >= 2 ? x2 : 0.f) + (fq >= 3 ? x3 : 0.f);
#pragma unroll
                  for (int r = 0; r < 4; ++r) lw[r] += base; }
#pragma unroll
                for (int r = 0; r < 4; ++r) { const int o = (4 * fq + r) * 64 + 16 * pw + fr;
                    EP[o] = __expf(lw[r]); EN[o] = __expf(-lw[r]); Aa[o] = fsigm(a0c + d1[r]); Gg[(4 * fq + r) * 68 + 16 * pw + fr] = d2[r]; }
            }
            RW_BAR();
            if (doprep) {
                const int o = tok * 64 + 4 * cq, ob = tok * R64 + 4 * cq;
                const f32x4 k4 = *(const LAS f32x4*)(Kp + o), a4 = *(const LAS f32x4*)(Aa + o), r4 = *(const LAS f32x4*)(Rr + o);
                f32x4 kk = k4 * kks4; const float ss = red16((kk.x * kk.x + kk.y * kk.y) + (kk.z * kk.z + kk.w * kk.w)); kk = kk * __builtin_amdgcn_rsqf(fmaxf(ss, 1e-24f));
                const f32x4 kp = k4 * (1.f + (a4 - 1.f) * kas4);
                const f32x4 ep = *(const LAS f32x4*)(EP + o), en = *(const LAS f32x4*)(EN + o);
                f32x4 epp = (f32x4){1.f, 1.f, 1.f, 1.f}; if (tok > 0) epp = *(const LAS f32x4*)(EP + o - 64);
                const f32x4 kat = kk * a4 * en, kpt = kp * en, rt = r4 * ep;
                { const f32x4 nn = -kk * epp; v2u w; w.x = pk2(nn.x, nn.y); w.y = pk2(nn.z, nn.w); *(LAS v2u*)(NB + ob) = w; }
                {
                    const bool real = tok < NST; const unsigned a01 = real ? pk2(kat.x, kat.y) : 0u, a23 = real ? pk2(kat.z, kat.w) : 0u, k01 = real ? pk2(kpt.x, kpt.y) : 0u, k23 = real ? pk2(kpt.z, kpt.w) : 0u;
                    LAS bf16* at = AKT + (4 * cq) * R32 + 8 * ((tok >> 3) ^ (cq & 3)) + (tok & 7); const int ak = 8 * ((2 + (tok >> 3)) ^ (cq & 3)) - 8 * ((tok >> 3) ^ (cq & 3));
                    at[0] = (bf16)(a01 & 0xffffu); at[R32] = (bf16)(a01 >> 16); at[2 * R32] = (bf16)(a23 & 0xffffu); at[3 * R32] = (bf16)(a23 >> 16);
                    at[ak] = (bf16)(k01 & 0xffffu); at[R32 + ak] = (bf16)(k01 >> 16); at[2 * R32 + ak] = (bf16)(k23 & 0xffffu); at[3 * R32 + ak] = (bf16)(k23 >> 16);
                }
                { v2u w; w.x = pk2(rt.x, rt.y); w.y = pk2(rt.z, rt.w); *(LAS v2u*)(RB + ob) = w; w.x = pk2(kat.x, kat.y); w.y = pk2(kat.z, kat.w); *(LAS v2u*)(AB + ob) = w; w.x = pk2(kpt.x, kpt.y); w.y = pk2(kpt.z, kpt.w); *(LAS v2u*)(KB + ob) = w; }
                if (tok == NST - 1) *(LAS f32x4*)(PWv + 4 * cq) = ep;
                const f32x4 rb = r4 * kp * rk4; const float bon = red16((rb.x + rb.y) + (rb.z + rb.w)); if (cq == 0) BON[tok] = bon;
            }
            RW_BAR();
        }
    }
    __syncthreads();
}

constexpr int ML_Q = 0;
constexpr int ML_K = ML_Q + 64 * 136 * 2;
constexpr int ML_KT = ML_K + 64 * 136 * 2;
constexpr int ML_VT = ML_KT + 128 * 72 * 2;
constexpr int ML_S = ML_VT + 64 * 72 * 2;
constexpr int ML_CT = ML_S + 64 * 72 * 2;
constexpr int ML_F = ML_CT + 64 * 136 * 2;
constexpr int ML_END = ML_F + (7 * 64 + 128) * 4;
static_assert(ML_K % 16 == 0 && ML_KT % 16 == 0 && ML_VT % 16 == 0 && ML_S % 16 == 0 && ML_CT % 16 == 0 && ML_F % 16 == 0 && ML_END <= LDS_CTL, "mlstm lds");

__device__ __forceinline__ void mlstm_item(const Args& A, LAS unsigned char* lds, bool prompt, int b0, int nseq, int h, int sl, int tid, int wid, int lane) {
    bf16* QKV = (bf16*)(A.ws + WS_QKV); const float* IFG = (const float*)(A.ws + WS_IFG);
    const int nch = prompt ? 33 : 1; const int nv0 = prompt ? 16 : 8;
    LAS bf16* Qs = (LAS bf16*)(lds + ML_Q); LAS bf16* Ks = (LAS bf16*)(lds + ML_K); LAS bf16* KT = (LAS bf16*)(lds + ML_KT); LAS bf16* VT = (LAS bf16*)(lds + ML_VT);
    LAS bf16* Ss = (LAS bf16*)(lds + ML_S); LAS bf16* CT = (LAS bf16*)(lds + ML_CT);
    LAS float* AS = (LAS float*)(lds + ML_F); LAS float* MX = AS + 64; LAS float* WINT = AS + 128; LAS float* EMR = AS + 192; LAS float* WK = AS + 256; LAS float* DEN1 = AS + 320; LAS float* DEN2 = AS + 384; LAS float* NV = AS + 448;
    const int fr = lane & 15, fq = lane >> 4;
    const int tm = wid >> 1, tn0 = (wid & 1) * 2;
    const float NEG_INF = -__builtin_inff();
    const int qk_tok0 = tid >> 4, qk_part = tid & 15, v_tok = tid >> 3, v_part = tid & 7;
    v4u pq[2], pk[2], pv;
    auto load_tiles = [&](int row_t0, int nvalid) {
#pragma unroll
        for (int i = 0; i < 2; ++i) { const int tok = qk_tok0 + 32 * i;
            if (tok < nvalid) { const bf16* rp = QKV + (size_t)(row_t0 + tok) * 2048 + h * 128 + qk_part * 8; pq[i] = *(const v4u*)rp; pk[i] = *(const v4u*)(rp + 512); }
            else { pq[i] = (v4u){0u, 0u, 0u, 0u}; pk[i] = (v4u){0u, 0u, 0u, 0u}; } }
        if (v_tok < nvalid) pv = *(const v4u*)(QKV + (size_t)(row_t0 + v_tok) * 2048 + 1024 + h * 256 + sl * 64 + v_part * 8); else pv = (v4u){0u, 0u, 0u, 0u};
    };
    f32x4 pC[4]; float pnv = 0.f, pmm = 0.f;
#pragma unroll
    for (int tn = 0; tn < 4; ++tn) pC[tn] = (f32x4){0.f, 0.f, 0.f, 0.f};
    auto load_state = [&](int b) {
        const float* C0 = A.in[I_MC] + (size_t)(b * 4 + h) * 128 * 256 + sl * 64;
#pragma unroll
        for (int tn = 0; tn < 4; ++tn)
#pragma unroll
            for (int r = 0; r < 4; ++r) pC[tn][r] = C0[(size_t)(16 * wid + 4 * fq + r) * 256 + 16 * tn + fr];
        if (tid < 128) pnv = A.in[I_MN][(size_t)(b * 4 + h) * 128 + tid];
        pmm = A.in[I_MM][b * 4 + h];
    };
    float gli = NEG_INF, gfp = 0.f;
    { const int row0 = prompt ? b0 * TP : NP + b0 * TS;
      if (!prompt) load_state(b0);
      load_tiles(row0, nv0);
      if (wid == 0 && lane < nv0) { gli = IFG[(size_t)(row0 + lane) * 8 + h]; gfp = IFG[(size_t)(row0 + lane) * 8 + 4 + h]; } }
    f32x4 oC[4]; float onv = 0.f, omm = 0.f; int ob = -1;
    f32x4 accC[4]; float m_state = 0.f;
    for (int sq = 0; sq < nseq; ++sq) {
        const int b = b0 + sq; const int row0 = prompt ? b * TP : NP + b * TS;
        __syncthreads();
#pragma unroll
        for (int tn = 0; tn < 4; ++tn) accC[tn] = pC[tn];
        if (tid < 128) NV[tid] = pnv;
        m_state = pmm;
#pragma unroll
        for (int tn = 0; tn < 4; ++tn) { v2u w; w.x = pk2(accC[tn][0], accC[tn][1]); w.y = pk2(accC[tn][2], accC[tn][3]); *(LAS v2u*)(CT + (16 * tn + fr) * 136 + 16 * wid + 4 * fq) = w; }
        if (sq + 1 < nseq) load_state(b + 1);
        for (int c = 0; c < nch; ++c) {
            const int t0 = prompt ? (c == 0 ? 0 : 16 + 64 * (c - 1)) : 0; const int nvalid = prompt ? (c == 0 ? 16 : 64) : 8;
            RW_BAR();
            if (wid == 0) {
                const bool valid = lane < nvalid;
                float li = NEG_INF, lf = 0.f;
                if (valid) { li = gli; const float fp = gfp; lf = fminf(fp, 0.f) - __logf(1.f + __expf(-fabsf(fp))); }
                if (c + 1 < nch) { const size_t rn = (size_t)(row0 + 16 + 64 * c + lane); gli = IFG[rn * 8 + h]; gfp = IFG[rn * 8 + 4 + h]; }
                else if (sq + 1 < nseq) { gli = NEG_INF; gfp = 0.f; if (lane < nv0) { const size_t rn = (size_t)(row0 + TS + lane); gli = IFG[rn * 8 + h]; gfp = IFG[rn * 8 + 4 + h]; } }
                const float bsum = wave_scan_sum(lf);
                const float a = valid ? li - bsum : NEG_INF;
                const float pm = wave_scan_max(a);
                const float mx = fmaxf(m_state, pm);
                const float blast = __builtin_bit_cast(float, __builtin_amdgcn_readlane(__builtin_bit_cast(int, bsum), 63)), mx63 = __builtin_bit_cast(float, __builtin_amdgcn_readlane(__builtin_bit_cast(int, mx), 63));
                AS[lane] = a; MX[lane] = mx; WINT[lane] = __expf(m_state - mx); EMR[lane] = __expf(-(bsum + mx)); WK[lane] = __expf(a - mx63);
                m_state = blast + mx63;
            }
            RW_BAR();
            {
                const float ksc = 0.08838834764831845f;
#pragma unroll
                for (int i = 0; i < 2; ++i) { const int tok = qk_tok0 + 32 * i;
                    *(LAS v4u*)(Qs + tok * 136 + qk_part * 8) = pq[i];
                    const float wk = WK[tok]; const v4u kr = pk[i];
                    float kf[8] = {bflo(kr.x) * ksc, bfhi(kr.x) * ksc, bflo(kr.y) * ksc, bfhi(kr.y) * ksc, bflo(kr.z) * ksc, bfhi(kr.z) * ksc, bflo(kr.w) * ksc, bfhi(kr.w) * ksc};
                    v4u ko; ko.x = pk2(kf[0], kf[1]); ko.y = pk2(kf[2], kf[3]); ko.z = pk2(kf[4], kf[5]); ko.w = pk2(kf[6], kf[7]);
                    *(LAS v4u*)(Ks + tok * 136 + qk_part * 8) = ko;
#pragma unroll
                    for (int j = 0; j < 8; ++j) KT[(qk_part * 8 + j) * 72 + 8 * ((tok >> 3) ^ (qk_part & 7)) + (tok & 7)] = bf1(kf[j] * wk); }
                const unsigned vr[4] = {pv.x, pv.y, pv.z, pv.w};
#pragma unroll
                for (int j = 0; j < 4; ++j) { const int vc = 8 * ((v_tok >> 3) ^ v_part) + (v_tok & 7); VT[(v_part * 8 + 2 * j) * 72 + vc] = (bf16)(vr[j] & 0xffffu); VT[(v_part * 8 + 2 * j + 1) * 72 + vc] = (bf16)(vr[j] >> 16); }
            }
            if (c + 1 < nch) load_tiles(row0 + 16 + 64 * c, 64);
            else if (sq + 1 < nseq) load_tiles(row0 + TS, nv0);
            if (ob >= 0) {
                float* Cout = A.out + O_SC + (size_t)(ob * 4 + h) * 128 * 256 + sl * 64;
#pragma unroll
                for (int tn = 0; tn < 4; ++tn)
#pragma unroll
                    for (int r = 0; r < 4; ++r) Cout[(size_t)(16 * wid + 4 * fq + r) * 256 + 16 * tn + fr] = oC[tn][r];
                if (sl == 0) { if (tid < 128) A.out[O_SN + (size_t)(ob * 4 + h) * 128 + tid] = onv; if (tid == 0) A.out[O_SM + ob * 4 + h] = omm; }
                ob = -1;
            }
            RW_BAR();
#pragma unroll
            for (int tt = 0; tt < 2; ++tt) { const int tn = tn0 + tt; f32x4 d = (f32x4){0.f, 0.f, 0.f, 0.f};
#pragma unroll
                for (int ks = 0; ks < 4; ++ks) d = __builtin_amdgcn_mfma_f32_16x16x32_bf16(*(const LAS bf16x8*)(Qs + (16 * tm + fr) * 136 + 32 * ks + 8 * fq), *(const LAS bf16x8*)(Ks + (16 * tn + fr) * 136 + 32 * ks + 8 * fq), d, 0, 0, 0);
                const int s = 16 * tn + fr; const float as = AS[s];
#pragma unroll
                for (int r = 0; r < 4; ++r) { const int t = 16 * tm + 4 * fq + r; const float e = __expf(fminf(as - MX[t], 0.f)); const float val = s <= t ? d[r] * e : 0.f; Ss[t * 72 + s] = bf1(val); } }
            RW_BAR();
            {
                const int dt = tid >> 3, dp = tid & 7;
                const v4u xs = *(const LAS v4u*)(Ss + dt * 72 + 8 * dp);
                float s1 = (bflo(xs.x) + bfhi(xs.x)) + (bflo(xs.y) + bfhi(xs.y)) + (bflo(xs.z) + bfhi(xs.z)) + (bflo(xs.w) + bfhi(xs.w));
                const v4u q0 = *(const LAS v4u*)(Qs + dt * 136 + 16 * dp), q1 = *(const LAS v4u*)(Qs + dt * 136 + 16 * dp + 8); const LAS float* nv = NV + 16 * dp;
                const f32x4 n0 = *(const LAS f32x4*)nv, n1 = *(const LAS f32x4*)(nv + 4), n2 = *(const LAS f32x4*)(nv + 8), n3 = *(const LAS f32x4*)(nv + 12);
                float s2 = (bflo(q0.x) * n0.x + bfhi(q0.x) * n0.y) + (bflo(q0.y) * n0.z + bfhi(q0.y) * n0.w) + (bflo(q0.z) * n1.x + bfhi(q0.z) * n1.y) + (bflo(q0.w) * n1.z + bfhi(q0.w) * n1.w)
                         + (bflo(q1.x) * n2.x + bfhi(q1.x) * n2.y) + (bflo(q1.y) * n2.z + bfhi(q1.y) * n2.w) + (bflo(q1.z) * n3.x + bfhi(q1.z) * n3.y) + (bflo(q1.w) * n3.z + bfhi(q1.w) * n3.w);
                s1 = red8(s1); s2 = red8(s2);
                if (dp == 0) { DEN1[dt] = s1; DEN2[dt] = s2; }
            }
            f32x4 nsv[2], nqc[2];
#pragma unroll
            for (int tt = 0; tt < 2; ++tt) { const int tn = tn0 + tt; f32x4 d = (f32x4){0.f, 0.f, 0.f, 0.f}, e = (f32x4){0.f, 0.f, 0.f, 0.f};
#pragma unroll
                for (int ks = 0; ks < 2; ++ks) d = __builtin_amdgcn_mfma_f32_16x16x32_bf16(*(const LAS bf16x8*)(Ss + (16 * tm + fr) * 72 + 32 * ks + 8 * fq), *(const LAS bf16x8*)(VT + (16 * tn + fr) * 72 + 8 * ((4 * ks + fq) ^ (((16 * tn + fr) >> 3) & 7))), d, 0, 0, 0);
#pragma unroll
                for (int ks = 0; ks < 4; ++ks) e = __builtin_amdgcn_mfma_f32_16x16x32_bf16(*(const LAS bf16x8*)(Qs + (16 * tm + fr) * 136 + 32 * ks + 8 * fq), *(const LAS bf16x8*)(CT + (16 * tn + fr) * 136 + 32 * ks + 8 * fq), e, 0, 0, 0);
                nsv[tt] = d; nqc[tt] = e; }
            RW_BAR();
#pragma unroll
            for (int r = 0; r < 4; ++r) { const int t = 16 * tm + 4 * fq + r; const float wi = WINT[t]; const float den = DEN1[t] + wi * DEN2[t]; const float inv = 1.f / fmaxf(fabsf(den), EMR[t]);
                if (t < nvalid) {
#pragma unroll
                    for (int tt = 0; tt < 2; ++tt) { const float hv = (nsv[tt][r] + wi * nqc[tt][r]) * inv;
                        QKV[(size_t)(row0 + t0 + t) * 2048 + 1024 + h * 256 + sl * 64 + 16 * (tn0 + tt) + fr] = bf1(hv); } } }
            {
                const float decay = WINT[63];
#pragma unroll
                for (int tn = 0; tn < 4; ++tn) { f32x4 d = accC[tn] * decay;
#pragma unroll
                    for (int ks = 0; ks < 2; ++ks) d = __builtin_amdgcn_mfma_f32_16x16x32_bf16(*(const LAS bf16x8*)(KT + (16 * wid + fr) * 72 + 8 * ((4 * ks + fq) ^ (((16 * wid + fr) >> 3) & 7))), *(const LAS bf16x8*)(VT + (16 * tn + fr) * 72 + 8 * ((4 * ks + fq) ^ (((16 * tn + fr) >> 3) & 7))), d, 0, 0, 0);
                    accC[tn] = d;
                    v2u w; w.x = pk2(d[0], d[1]); w.y = pk2(d[2], d[3]); *(LAS v2u*)(CT + (16 * tn + fr) * 136 + 16 * wid + 4 * fq) = w; }
                {   const int nk = tid >> 2, np = tid & 3;
                    const v4u x = *(const LAS v4u*)(KT + nk * 72 + 16 * np), y = *(const LAS v4u*)(KT + nk * 72 + 16 * np + 8);
                    float s = ((bflo(x.x) + bfhi(x.x)) + (bflo(x.y) + bfhi(x.y))) + ((bflo(x.z) + bfhi(x.z)) + (bflo(x.w) + bfhi(x.w))) + ((bflo(y.x) + bfhi(y.x)) + (bflo(y.y) + bfhi(y.y))) + ((bflo(y.z) + bfhi(y.z)) + (bflo(y.w) + bfhi(y.w)));
                    s += dppf<0xB1>(s); s += dppf<0x4E>(s);
                    if (np == 0) NV[nk] = decay * NV[nk] + s; }
            }
        }
        __syncthreads();
        if (!prompt && sq + 1 < nseq) {
#pragma unroll
            for (int tn = 0; tn < 4; ++tn) oC[tn] = accC[tn];
            onv = tid < 128 ? NV[tid] : 0.f; omm = m_state; ob = b;
        } else {
            float* Cout = A.out + (prompt ? O_PC : O_SC) + (size_t)(b * 4 + h) * 128 * 256 + sl * 64;
#pragma unroll
            for (int tn = 0; tn < 4; ++tn)
#pragma unroll
                for (int r = 0; r < 4; ++r) Cout[(size_t)(16 * wid + 4 * fq + r) * 256 + 16 * tn + fr] = accC[tn][r];
            if (sl == 0) {
                if (tid < 128) A.out[(prompt ? O_PN : O_SN) + (size_t)(b * 4 + h) * 128 + tid] = NV[tid];
                if (tid == 0) A.out[(prompt ? O_PM : O_SM) + b * 4 + h] = m_state;
            }
        }
    }
    __syncthreads();
}

__device__ __forceinline__ void merge_rows(const Args& A, int gw, int NGW, int lane) {
    const unsigned char* G1 = (const unsigned char*)A.out; const bf16* QKV = (const bf16*)(A.ws + WS_QKV); bf16* HB = (bf16*)(A.ws + WS_PB); const float* ng = A.in[I_MNG];
    const int c0 = 16 * lane;
    float ngv[16];
#pragma unroll
    for (int i = 0; i < 4; ++i) { const f32x4 t = *(const f32x4*)(ng + c0 + 4 * i); ngv[4 * i] = t.x; ngv[4 * i + 1] = t.y; ngv[4 * i + 2] = t.z; ngv[4 * i + 3] = t.w; }
    v4u nha[2], nhb[2], nga, ngb, noa;
#define MERGE_LD(mm) do { const v4u* hap_ = (const v4u*)(QKV + (size_t)(mm) * 2048 + 1024 + c0); const v4u* hbp_ = (const v4u*)(HB + (size_t)(mm) * PBW + c0); nha[0] = hap_[0]; nha[1] = hap_[1]; nhb[0] = hbp_[0]; nhb[1] = hbp_[1]; \
        nga = *(const v4u*)(G1 + (size_t)(mm) * 3072 + c0); ngb = *(const v4u*)(G1 + (size_t)(mm) * 3072 + 1024 + c0); noa = *(const v4u*)(G1 + (size_t)(mm) * 3072 + 2048 + c0); } while (0)
    if (gw < NTOK) MERGE_LD(gw);
    for (int m = gw; m < NTOK; m += NGW) {
        const v4u hap[2] = {nha[0], nha[1]}, hbp[2] = {nhb[0], nhb[1]}; const v4u ga = nga, gb = ngb, oa = noa;
        if (m + NGW < NTOK) MERGE_LD(m + NGW);
        float ha[16], o[16];
#pragma unroll
        for (int i = 0; i < 2; ++i) { const v4u x = hap[i]; ha[8 * i + 0] = bflo(x.x); ha[8 * i + 1] = bfhi(x.x); ha[8 * i + 2] = bflo(x.y); ha[8 * i + 3] = bfhi(x.y); ha[8 * i + 4] = bflo(x.z); ha[8 * i + 5] = bfhi(x.z); ha[8 * i + 6] = bflo(x.w); ha[8 * i + 7] = bfhi(x.w); }
        float s = 0.f;
#pragma unroll
        for (int i = 0; i < 16; ++i) s += ha[i];
        const float mean = red16(s) * (1.f / 256.f); float q = 0.f;
#pragma unroll
        for (int i = 0; i < 16; ++i) { ha[i] -= mean; q += ha[i] * ha[i]; }
        const float rstd = __builtin_amdgcn_rsqf(red16(q) * (1.f / 256.f) + LN_EPS);
        const unsigned gav[4] = {ga.x, ga.y, ga.z, ga.w}, gbv[4] = {gb.x, gb.y, gb.z, gb.w}, oav[4] = {oa.x, oa.y, oa.z, oa.w};
#pragma unroll
        for (int i = 0; i < 2; ++i) { const v4u hb = hbp[i]; const unsigned hbv[4] = {hb.x, hb.y, hb.z, hb.w};
#pragma unroll
            for (int j = 0; j < 4; ++j) { const int e = 8 * i + 2 * j; const int wq = e >> 2, sh = (e & 3) * 8;
                const float n0 = ngv[e], n1 = ngv[e + 1]; const float k255 = 1.f / 255.f;
                const float sa0 = (float)((gav[wq] >> sh) & 0xffu) * k255, sa1 = (float)((gav[wq] >> (sh + 8)) & 0xffu) * k255;
                const float sb0 = (float)((gbv[wq] >> sh) & 0xffu) * k255, sb1 = (float)((gbv[wq] >> (sh + 8)) & 0xffu) * k255;
                const float so0 = (float)((oav[wq] >> sh) & 0xffu) * k255, so1 = (float)((oav[wq] >> (sh + 8)) & 0xffu) * k255;
                o[e] = sa0 * (ha[e] * rstd * n0 * so0) + sb0 * bflo(hbv[j]);
                o[e + 1] = sa1 * (ha[e + 1] * rstd * n1 * so1) + sb1 * bfhi(hbv[j]); } }
        v4u* op = (v4u*)(HB + (size_t)m * PBW + c0);
#pragma unroll
        for (int i = 0; i < 2; ++i) { v4u w; w.x = pk2(o[8 * i], o[8 * i + 1]); w.y = pk2(o[8 * i + 2], o[8 * i + 3]); w.z = pk2(o[8 * i + 4], o[8 * i + 5]); w.w = pk2(o[8 * i + 6], o[8 * i + 7]); op[i] = w; }
    }
}
template <bool TO_BF16> __device__ __forceinline__ void ln_rows(const float* src, void* dst, const float* g, const float* bta, int nrows, int gw, int NGW, int lane, const float* part = nullptr, const LAS signed char* tmap = nullptr) {
    f32x4 nx[4];
    if (gw < nrows) { const f32x4* xr = (const f32x4*)(src + (size_t)gw * DM) + lane;
#pragma unroll
        for (int j = 0; j < 4; ++j) nx[j] = xr[64 * j]; }
    for (int m = gw; m < nrows; m += NGW) {
        f32x4 v[4]; float s = 0.f;
#pragma unroll
        for (int j = 0; j < 4; ++j) v[j] = nx[j];
        if (part) {
            const int r = m < 16384 ? (m >> 11) * TP + (m & 2047) + NMETA : m + 128; const int pm = r >> 8, rit = r & 255;
#pragma unroll
            for (int j = 0; j < 4; ++j) { const int ix = tmap[pm * 4 + j]; if (ix >= 0) v[j] = (v[j] + *(const f32x4*)(part + (size_t)(2 * ix) * 65536 + (size_t)rit * 256 + 4 * lane)) + *(const f32x4*)(part + (size_t)(2 * ix + 1) * 65536 + (size_t)rit * 256 + 4 * lane); }
        }
#pragma unroll
        for (int j = 0; j < 4; ++j) s += (v[j].x + v[j].y) + (v[j].z + v[j].w);
        if (m + NGW < nrows) { const f32x4* xr = (const f32x4*)(src + (size_t)(m + NGW) * DM) + lane;
#pragma unroll
            for (int j = 0; j < 4; ++j) nx[j] = xr[64 * j]; }
        const float mean = wave_sum(s) * (1.f / DM); float s2 = 0.f;
#pragma unroll
        for (int j = 0; j < 4; ++j) { v[j] = v[j] - mean; s2 += (v[j].x * v[j].x + v[j].y * v[j].y) + (v[j].z * v[j].z + v[j].w * v[j].w); }
        const float rstd = __builtin_amdgcn_rsqf(wave_sum(s2) * (1.f / DM) + LN_EPS);
#pragma unroll
        for (int j = 0; j < 4; ++j) { const f32x4 gg = ((const f32x4*)g)[lane + 64 * j], bb = ((const f32x4*)bta)[lane + 64 * j]; v[j] = v[j] * rstd * gg + bb; }
        if (TO_BF16) { unsigned long long* o8 = (unsigned long long*)((bf16*)dst + (size_t)m * DM) + lane;
#pragma unroll
            for (int j = 0; j < 4; ++j) o8[64 * j] = (unsigned long long)pk2(v[j].x, v[j].y) | ((unsigned long long)pk2(v[j].z, v[j].w) << 32); }
        else { f32x4* o = (f32x4*)((float*)dst + (size_t)m * DM) + lane;
#pragma unroll
            for (int j = 0; j < 4; ++j) o[64 * j] = v[j]; }
    }
}
__device__ __forceinline__ float gelu_tanh(float x) { const float u = 0.7978845608028654f * (x + 0.044715f * x * x * x); return 0.5f * x * (1.f + tanhf_(u)); }
__device__ __forceinline__ void unpack8(const v4u x, float (&f)[8]) { f[0] = bflo(x.x); f[1] = bfhi(x.x); f[2] = bflo(x.y); f[3] = bfhi(x.y); f[4] = bflo(x.z); f[5] = bfhi(x.z); f[6] = bflo(x.w); f[7] = bfhi(x.w); }
__device__ __forceinline__ void conv_pass(const Args& A, int gtid, int nthr) {
    bf16* UP = (bf16*)(A.ws + WS_UP); const float* cw = A.in[I_CW]; const float* cb = A.in[I_CB];
    constexpr int NG = DFF / 8;
    const int nitems = (NTOK / 8) * NG;
    for (int it = gtid; it < nitems; it += nthr) {
        const int rb = it / NG, fg = it - rb * NG; const int ff = 8 * fg; const int row0 = 8 * rb;
        const int pc = 256 * (ff >> 7) + (ff & 127);
        bool prompt = row0 < NP; int seq, t0, T;
        if (prompt) { seq = row0 / TP; t0 = row0 - seq * TP; T = TP; } else { seq = (row0 - NP) >> 3; t0 = 0; T = TS; }
        float w0[8], w1[8], w2[8], bb[8], g1[8], g2[8];
        { const f32x4* p = (const f32x4*)(cw + ff); const f32x4 a = p[0], b = p[1]; w0[0] = a.x; w0[1] = a.y; w0[2] = a.z; w0[3] = a.w; w0[4] = b.x; w0[5] = b.y; w0[6] = b.z; w0[7] = b.w; }
        { const f32x4* p = (const f32x4*)(cw + DFF + ff); const f32x4 a = p[0], b = p[1]; w1[0] = a.x; w1[1] = a.y; w1[2] = a.z; w1[3] = a.w; w1[4] = b.x; w1[5] = b.y; w1[6] = b.z; w1[7] = b.w; }
        { const f32x4* p = (const f32x4*)(cw + 2 * DFF + ff); const f32x4 a = p[0], b = p[1]; w2[0] = a.x; w2[1] = a.y; w2[2] = a.z; w2[3] = a.w; w2[4] = b.x; w2[5] = b.y; w2[6] = b.z; w2[7] = b.w; }
        { const f32x4* p = (const f32x4*)(cb + ff); const f32x4 a = p[0], b = p[1]; bb[0] = a.x; bb[1] = a.y; bb[2] = a.z; bb[3] = a.w; bb[4] = b.x; bb[5] = b.y; bb[6] = b.z; bb[7] = b.w; }
        if (t0 > 0) { unpack8(*(const v4u*)(UP + (size_t)(row0 - 2) * 5632 + pc), g2); unpack8(*(const v4u*)(UP + (size_t)(row0 - 1) * 5632 + pc), g1); }
        else if (!prompt) { const float* c0 = A.in[I_FCV] + (size_t)seq * 2 * DFF + ff;
#pragma unroll
            for (int j = 0; j < 8; ++j) { g2[j] = c0[j]; g1[j] = c0[DFF + j]; } }
        else {
#pragma unroll
            for (int j = 0; j < 8; ++j) { g2[j] = 0.f; g1[j] = 0.f; } }
#pragma unroll
        for (int r = 0; r < 8; ++r) {
            bf16* rp = UP + (size_t)(row0 + r) * 5632 + pc; float g0[8], vv[8], o[8];
            unpack8(*(const v4u*)rp, g0); unpack8(*(const v4u*)(rp + 128), vv);
#pragma unroll
            for (int j = 0; j < 8; ++j) { const float cv = bb[j] + w0[j] * g2[j] + w1[j] * g1[j] + w2[j] * g0[j]; o[j] = gelu_tanh(cv) * vv[j]; g2[j] = g1[j]; g1[j] = g0[j]; }
            v4u w; w.x = pk2(o[0], o[1]); w.y = pk2(o[2], o[3]); w.z = pk2(o[4], o[5]); w.w = pk2(o[6], o[7]); *(v4u*)(rp + 128) = w;
        }
        if (t0 + 8 == T) {
            float* co = A.out + (prompt ? O_PCV : O_SCV) + (size_t)seq * 2 * DFF + ff;
#pragma unroll
            for (int j = 0; j < 8; ++j) { co[j] = g2[j]; co[DFF + j] = g1[j]; } }
    }
}

#define RLX_AGENT __ATOMIC_RELAXED, __HIP_MEMORY_SCOPE_AGENT
#define XB_TMO      128
#define XB_XCNT(j)  (256  + 64 * (j))
#define XB_XSUB(j)  (1280 + 64 * (j))
#define XB_XGEN(j)  (2304 + 64 * (j))
#define XB_TOP      3328
#define XB_TOPGEN   3392
#define XCD_BAR_WORDS 3456
#define XB_SPIN_CAP (1u << 18)

__device__ __forceinline__ unsigned xb_ld(unsigned* p)              { return __hip_atomic_load(p, __ATOMIC_RELAXED, __HIP_MEMORY_SCOPE_AGENT); }
__device__ __forceinline__ unsigned xb_add(unsigned* p, unsigned v) { return __hip_atomic_fetch_add(p, v, __ATOMIC_RELAXED, __HIP_MEMORY_SCOPE_AGENT); }
__device__ __forceinline__ unsigned xb_xcc_id() { return (unsigned)__builtin_amdgcn_s_getreg((3 << 11) | 20) & 0xFu; }
#define XB_SPIN(cond, bar) do { unsigned _sp = 0; while (cond) { __builtin_amdgcn_s_sleep(1); \
    if ((++_sp & 255u) == 0u) { if (xb_ld(&(bar)[XB_TMO])) break; if (_sp > XB_SPIN_CAP) { atomicAdd(&(bar)[XB_TMO], 1u); break; } } } } while (0)

struct XcdBarrier {
    unsigned* bar; unsigned x;
    volatile LAS unsigned* st;
};

__device__ __forceinline__ XcdBarrier xcd_barrier_post(unsigned* bar, volatile LAS unsigned* st) {
    XcdBarrier b; b.bar = bar; b.x = xb_xcc_id(); b.st = st;
    if (threadIdx.x == 0) (void)xb_add(&bar[XB_XCNT(b.x)], 1u);
    return b;
}
__device__ __forceinline__ void xcd_barrier_complete(unsigned* bar, unsigned x, unsigned& nloc, unsigned& nx) {
    const unsigned G = gridDim.x * gridDim.y * gridDim.z;
    unsigned sum, cnt, mine, sp = 0u;
    for (;;) {
        sum = 0u; cnt = 0u; mine = 0u;
#pragma unroll
        for (unsigned j = 0; j < 16; ++j) { const unsigned c = xb_ld(&bar[XB_XCNT(j)]); sum += c; cnt += (c > 0u) ? 1u : 0u; mine = (j == x) ? c : mine; }
        if (sum == G) break;
        __builtin_amdgcn_s_sleep(1);
        if ((++sp & 255u) == 0u) { if (xb_ld(&bar[XB_TMO])) break; if (sp > XB_SPIN_CAP) { atomicAdd(&bar[XB_TMO], 1u); break; } }
    }
    nloc = mine > 0u ? mine : 1u; nx = cnt > 0u ? cnt : 1u;
}

__device__ __forceinline__ void xcd_barrier(const XcdBarrier& b) {
    asm volatile("s_waitcnt vmcnt(0)" ::: "memory");
    __syncthreads();
    if (threadIdx.x == 0) {
        unsigned* bar = b.bar;
        __builtin_amdgcn_s_waitcnt(0);
        unsigned nloc = b.st[0], nx = b.st[1];
        if (nloc == 0u) { xcd_barrier_complete(bar, b.x, nloc, nx); b.st[0] = nloc; b.st[1] = nx; }
        const unsigned old = xb_add(&bar[XB_XSUB(b.x)], 1u);
        const unsigned gen = old / nloc;
        if (old + 1u == (gen + 1u) * nloc) {
            __builtin_amdgcn_fence(__ATOMIC_RELEASE, "agent");
            asm volatile("s_waitcnt vmcnt(0)" ::: "memory");
            const unsigned og = xb_add(&bar[XB_TOP], 1u);
            const unsigned tg = og / nx;
            if (og + 1u == (tg + 1u) * nx) xb_add(&bar[XB_TOPGEN], 1u);
            else XB_SPIN(xb_ld(&bar[XB_TOPGEN]) == tg, bar);
            __builtin_amdgcn_fence(__ATOMIC_ACQUIRE, "agent");
            xb_add(&bar[XB_XGEN(b.x)], 1u);
            asm volatile("s_waitcnt vmcnt(0)" ::: "memory");
        } else {
            XB_SPIN(xb_ld(&bar[XB_XGEN(b.x)]) == gen, bar);
            __builtin_amdgcn_fence(__ATOMIC_ACQUIRE, "agent");
            asm volatile("s_waitcnt vmcnt(0)" ::: "memory");
        }
    }
    __syncthreads();
}

__global__ void __launch_bounds__(512, 2) fwd_megakernel(Args A) {
    extern __shared__ __attribute__((aligned(16))) unsigned char lds_raw[];
    cg::grid_group grid = cg::this_grid();
    LAS unsigned char* lds = (LAS unsigned char*)lds_raw;
    const int G = gridDim.x, bid = blockIdx.x, NGW = G * 8;
    if (threadIdx.x < 32) ((LAS unsigned*)(lds + LDS_CTL))[threadIdx.x] = 0u;
    __syncthreads();
    XcdBarrier bar = xcd_barrier_post((unsigned*)(A.ws + WS_CTL) + 4096, (volatile LAS unsigned*)(lds + LDS_CTL + 64));
#define FRESH() int tid = threadIdx.x; asm volatile("" : "+v"(tid)); const int lane = tid & 63, wid = __builtin_amdgcn_readfirstlane(tid >> 6), gw = bid * 8 + wid; (void)lane; (void)gw
    unsigned char* ws = A.ws;
    bf16* XN = (bf16*)(ws + WS_XN); bf16* WinT = (bf16*)(ws + WS_WIN); bf16* WoT = (bf16*)(ws + WS_WO); bf16* WupT = (bf16*)(ws + WS_WUP); bf16* WdT = (bf16*)(ws + WS_WD);
    bf16* PB = (bf16*)(ws + WS_PB); bf16* QKV = (bf16*)(ws + WS_QKV); bf16* G1 = (bf16*)(ws + WS_G1); float* PRE1 = (float*)(ws + WS_PRE1); bf16* UP = (bf16*)(ws + WS_UP);

    { FRESH(); p0_prologue(A, lds, gw, NGW, wid, lane, tid, G >= 256); }
    grid.sync();
    { pg8::Gemm g{XN, WinT, MROWS, 5376, 1024, 1024, 256}; pg8::StaticOrder S; S.init(MROWS, 5376, G, bid);
      pg8::EpiProj E{PB, PBW, 13, QKV, 2048};
      pg8::gemm_phase<pg8::EpiProj, pg8::StaticOrder, true, true>(lds, g, S, E); }
    xcd_barrier(bar);
    { FRESH(); lora_act_pass(A, bid * 512 + tid, G * 512); }
    xcd_barrier(bar);
    {
        const int nrw = (G >= 256) ? 128 : 0;
        if (bid < nrw) {
            int tid = threadIdx.x; asm volatile("" : "+v"(tid)); const int lane = tid & 63, wid = __builtin_amdgcn_readfirstlane(tid >> 6);
            rwkv_item<true>(A, lds, bid >> 4, 1, bid & 15, tid, wid, lane);
            pg8::Gemm g{XN, WinT + (size_t)5376 * 1024, MROWS, 3072, 1024, 1024, 256}; pg8::StaticOrder S; S.init(MROWS, 3072, nrw, bid); S.off = G1_SPLIT;
            pg8::EpiSigU8 E{(unsigned char*)A.out, 3072};
            pg8::gemm_phase<pg8::EpiSigU8, pg8::StaticOrder, true, true>(lds, g, S, E);
        } else {
            unsigned* ctr = (unsigned*)(ws + WS_CTL);
            LAS unsigned* qslot = (LAS unsigned*)(lds + LDS_CTL);
            for (;;) {
                int tid = threadIdx.x; asm volatile("" : "+v"(tid)); const int lane = tid & 63, wid = __builtin_amdgcn_readfirstlane(tid >> 6);
                if (tid == 0) qslot[0] = (unsigned)nrw + atomicAdd(ctr, 1u);
                __syncthreads();
                const int q = (int)qslot[0];
                __syncthreads();
                if (q >= 512 + 256) break;
                if (q < 128) rwkv_item<true>(A, lds, q >> 4, 1, q & 15, tid, wid, lane);
                else if (q < 256) { const int i = q - 128; mlstm_item(A, lds, true, i >> 4, 1, (i >> 2) & 3, i & 3, tid, wid, lane); }
                else if (q < 512) { const int i = q - 256; rwkv_item<false>(A, lds, (i >> 4) * 8, 8, i & 15, tid, wid, lane); }
                else { const int i = q - 512; mlstm_item(A, lds, false, (i >> 4) * 8, 8, (i >> 2) & 3, i & 3, tid, wid, lane); }
            }
            pg8::Gemm g{XN, WinT + (size_t)5376 * 1024, MROWS, 3072, 1024, 1024, 256}; pg8::StaticOrder S; S.init(MROWS, 3072, G - nrw, bid - nrw); S.end = nrw ? G1_SPLIT : 0;
            pg8::EpiSigU8 E{(unsigned char*)A.out, 3072};
            pg8::gemm_phase<pg8::EpiSigU8, pg8::StaticOrder, true, true>(lds, g, S, E);
            if (nrw) { int tq = threadIdx.x; asm volatile("" : "+v"(tq)); const int wq = __builtin_amdgcn_readfirstlane(tq >> 6); __syncthreads(); weight_items(A, lds, 1, (bid - nrw) * 8 + wq, (G - nrw) * 8, wq, tq & 63); }
        }
    }
    xcd_barrier(bar);
    { FRESH(); merge_rows(A, gw, NGW, lane); }
    xcd_barrier(bar);
    { pg8::Gemm g{PB, WoT, MROWS, 1024, 1024, PBW, 256}; pg8::StaticOrder S; S.init(MROWS, 1024, G, bid);
      pg8::EpiRes<false> E{XN, PRE1, ALPHA, nullptr};
      pg8::gemm_phase<pg8::EpiRes<false>, pg8::StaticOrder, true, true>(lds, g, S, E); }
    xcd_barrier(bar);
    { FRESH(); ln_rows<true>(PRE1, XN, A.in[I_L1G], A.in[I_L1B], NTOK, gw, NGW, lane); }
    xcd_barrier(bar);
    { pg8::Gemm g{XN, WupT, MROWS, 5632, 1024, 1024, 256}; pg8::StaticOrder S; S.init(MROWS, 5632, G, bid);
      pg8::EpiProj E{UP, 5632, 1 << 20, UP, 5632};
      pg8::gemm_phase<pg8::EpiProj, pg8::StaticOrder, true, true>(lds, g, S, E); }
    xcd_barrier(bar);
    { FRESH(); conv_pass(A, bid * 512 + tid, G * 512); }
    xcd_barrier(bar);
    { pg8::Gemm g{UP + 128, WdT, MROWS, 1024, DFF, 5632, 512};
      pg8::EpiRes<true> E{XN, A.out, ALPHA, (float*)(ws + WS_PART)};
      if (G == 256) { pg8::TailSplitOrder S; S.init(MROWS, 1024, DFF, G, bid); pg8::gemm_phase<pg8::EpiRes<true>, pg8::TailSplitOrder, true, true>(lds, g, S, E); }
      else { pg8::StaticOrder S; S.init(MROWS, 1024, G, bid); pg8::gemm_phase<pg8::EpiRes<true>, pg8::StaticOrder, true, true>(lds, g, S, E); } }
    xcd_barrier(bar);
    { FRESH();
      LAS signed char* tmap = (LAS signed char*)lds;
      const bool tail = (G == 256);
      if (tid < 276) tmap[tid] = -1;
      __syncthreads();
      if (tail && tid < 20) { pg8::StaticOrder b1; b1.init(MROWS, 1024, 1, 0); pg8::Unit u; b1.next(256 + tid, u); tmap[u.pm * 4 + u.pn] = (signed char)tid; }
      __syncthreads();
      ln_rows<false>(A.out, A.out, A.in[I_L2G], A.in[I_L2B], 8 * 2048 + NS, gw, NGW, lane, tail ? (const float*)(ws + WS_PART) : nullptr, tmap); }
}

extern "C" void kernel_launch(void* const* d_in, const int* in_sizes, int n_in, void* d_out, int out_size, void* d_ws, size_t ws_size, hipStream_t stream) {
    static int grid = 0;
    if (grid == 0) {
        if (n_in != 34 || (size_t)out_size != O_END || ws_size < WS_END) { fprintf(stderr, "kernel_launch: unexpected shapes: n_in %d out %d ws %zu\n", n_in, out_size, ws_size); grid = -1; return; }
        int dev = 0, cus = 0, per_cu = 0;
        hipGetDevice(&dev); hipDeviceGetAttribute(&cus, hipDeviceAttributeMultiprocessorCount, dev);
        hipFuncSetAttribute((const void*)fwd_megakernel, hipFuncAttributeMaxDynamicSharedMemorySize, LDS_BYTES);
        hipOccupancyMaxActiveBlocksPerMultiprocessor(&per_cu, (const void*)fwd_megakernel, 512, LDS_BYTES);
        if (per_cu < 1) { fprintf(stderr, "kernel_launch: occupancy query says %d blocks per CU\n", per_cu); per_cu = 1; }
        grid = cus;
        (void)hipGetLastError();
    }
    if (grid < 0) return;
    hipMemsetAsync((char*)d_ws + WS_CTL, 0, 65536, stream);
    Args a{};
    for (int i = 0; i < 34; ++i) a.in[i] = (const float*)d_in[i];
    a.out = (float*)d_out; a.ws = (unsigned char*)d_ws;
    void* args[] = {&a};
    hipError_t e = hipLaunchCooperativeKernel((const void*)fwd_megakernel, dim3(grid), dim3(512), args, LDS_BYTES, stream);
    if (e != hipSuccess) fprintf(stderr, "cooperative launch failed: %s (grid %d)\n", hipGetErrorString(e), grid);
}
```
